# Optimizing an MI355X kernel written in HIP

```python
import math
import jax, jax.numpy as jnp
from jax import lax
import numpy as np

D_MODEL = 1024
BATCH = 8
SEQ = 4096
DEPTH = 2

HEAD_DIM = 64
ROPE_THETA = 10000.0
NORM_EPS = 1e-6
D_FF = 2816
BAND_BLOCK = 128
GATHER_CHUNK = 32
NEG_INF = -1e30
FORCE_SCORE = 1e4

A_Q_HEADS = 8
A_KV_HEADS = 2
A_WINDOW = 128
B_Q_HEADS = 8
B_KV_HEADS = 2
NSA_CMP_LEN = 32
NSA_CMP_STRIDE = 16
NSA_CMP_HIDDEN = 256
NSA_SEL_LEN = 64
NSA_SEL_COUNT = 8
NSA_WINDOW = 512
C_GROUPS = ((128, 1), (512, 4), (2048, 16))
C_HEADS_PER_GROUP = 4
C_HEADS = len(C_GROUPS) * C_HEADS_PER_GROUP
D_HEADS = 4
MOBA_BLOCK = 256
MOBA_TOPK = 3

EVEN_SIZES = ([A_Q_HEADS * HEAD_DIM] + [A_KV_HEADS * HEAD_DIM] * 2 + [B_Q_HEADS * HEAD_DIM]
              + [B_KV_HEADS * HEAD_DIM] * 6 + [3 * B_Q_HEADS])
EVEN_IN = sum(EVEN_SIZES)
EVEN_OUT = (A_Q_HEADS + B_Q_HEADS) * HEAD_DIM
ODD_SIZES = [C_HEADS * HEAD_DIM] * 3 + [D_HEADS * HEAD_DIM] * 3
ODD_IN = sum(ODD_SIZES)
ODD_OUT = (C_HEADS_PER_GROUP + D_HEADS) * HEAD_DIM
N_EVEN = (DEPTH + 1) // 2
N_ODD = DEPTH // 2

kernel_name = "hybrid_swa_nsa_dilated_moba_macaron"


def rms_norm(x, g):
    xf = x.astype(jnp.float32)
    y = xf * lax.rsqrt(jnp.mean(xf * xf, axis=-1, keepdims=True) + NORM_EPS)
    return (y * g.astype(jnp.float32)).astype(x.dtype)


def swiglu(x, wi, wo):
    gate, up = jnp.split(x @ wi, 2, axis=-1)
    return (jax.nn.silu(gate) * up) @ wo


def rope(x):
    T, dh = x.shape[-2], x.shape[-1]
    inv = 1.0 / (ROPE_THETA ** (jnp.arange(0, dh, 2, dtype=jnp.float32) / dh))
    ang = jnp.arange(T, dtype=jnp.float32)[:, None] * inv[None, :]
    cos = jnp.cos(ang).astype(x.dtype)
    sin = jnp.sin(ang).astype(x.dtype)
    x1, x2 = jnp.split(x, 2, axis=-1)
    return jnp.concatenate([x1 * cos - x2 * sin, x2 * cos + x1 * sin], axis=-1)


def to_heads(z, n):
    B, T, _ = z.shape
    return z.reshape(B, T, n, HEAD_DIM).transpose(0, 2, 1, 3)


def from_heads(o):
    B, H, T, dh = o.shape
    return o.transpose(0, 2, 1, 3).reshape(B, T, H * dh)


def split_cols(z, sizes):
    offs = []
    acc = 0
    for s in sizes[:-1]:
        acc += s
        offs.append(acc)
    return jnp.split(z, offs, axis=-1)


def masked_softmax_stats(s, mask, sink=None):
    s = jnp.where(mask, s, NEG_INF)
    m = jnp.max(s, axis=-1)
    if sink is not None:
        m = jnp.maximum(m, sink)
    p = jnp.where(mask, jnp.exp(s - m[..., None]), 0.0)
    denom = jnp.sum(p, axis=-1)
    if sink is not None:
        denom = denom + jnp.exp(sink - m)
    denom = jnp.where(denom > 0, denom, 1.0)
    return p, m, denom


def banded_attention(q, k, v, max_dist, sink=None):
    B, Hk, G, L, dh = q.shape
    bq = math.gcd(L, BAND_BLOCK)
    nb = L // bq
    nw = -(-max_dist // bq)
    pad = nw * bq
    kp = jnp.pad(k, ((0, 0), (0, 0), (pad, 0), (0, 0))).reshape(B, Hk, nb + nw, bq, dh)
    vp = jnp.pad(v, ((0, 0), (0, 0), (pad, 0), (0, 0))).reshape(B, Hk, nb + nw, bq, dh)
    kwin = jnp.concatenate([kp[:, :, j:j + nb] for j in range(nw + 1)], axis=3)
    vwin = jnp.concatenate([vp[:, :, j:j + nb] for j in range(nw + 1)], axis=3)
    qb = q.reshape(B, Hk, G, nb, bq, dh)
    s = jnp.einsum('bhgnqd,bhnkd->bhgnqk', qb, kwin).astype(jnp.float32) * (dh ** -0.5)
    qpos = jnp.arange(nb)[:, None] * bq + jnp.arange(bq)[None, :]
    kpos = jnp.arange(nb)[:, None] * bq - pad + jnp.arange((nw + 1) * bq)[None, :]
    dist = qpos[:, :, None] - kpos[:, None, :]
    mask = (dist >= 0) & (dist <= max_dist) & (kpos[:, None, :] >= 0)
    sink_b = None if sink is None else sink.astype(jnp.float32)[None, :, :, None, None]
    p, m, denom = masked_softmax_stats(s, mask, sink_b)
    o = jnp.einsum('bhgnqk,bhnkd->bhgnqd', p.astype(v.dtype), vwin).astype(jnp.float32)
    o = (o / denom[..., None]).astype(q.dtype)
    lse = m + jnp.log(denom)
    return o.reshape(B, Hk, G, L, dh), lse.reshape(B, Hk, G, L)


def gathered_block_attention(q, k_blocks, v_blocks, idx, valid):
    B, Hk, G, T, dh = q.shape
    bs = k_blocks.shape[3]
    K = idx.shape[-1]
    c = math.gcd(T, GATHER_CHUNK)
    nc = T // c
    qs = jnp.moveaxis(q.reshape(B, Hk, G, nc, c, dh), 3, 0)
    ids = jnp.moveaxis(idx.reshape(B, Hk, nc, c, K), 2, 0)
    vals = jnp.moveaxis(valid.reshape(B, Hk, nc, c, K), 2, 0)
    poss = jnp.arange(T).reshape(nc, c)
    take = jax.vmap(jax.vmap(lambda blocks, ix: blocks[ix]))
    scale = dh ** -0.5

    def chunk(args):
        qc, ic, vc, pc = args
        kg = take(k_blocks, ic).reshape(B, Hk, c, K * bs, dh)
        vg = take(v_blocks, ic).reshape(B, Hk, c, K * bs, dh)
        kpos = (ic[..., None] * bs + jnp.arange(bs)).reshape(B, Hk, c, K * bs)
        mask = jnp.repeat(vc, bs, axis=-1) & (kpos <= pc[:, None])
        s = jnp.einsum('bhgcd,bhckd->bhgck', qc, kg).astype(jnp.float32) * scale
        p, _, denom = masked_softmax_stats(s, mask[:, :, None])
        o = jnp.einsum('bhgck,bhckd->bhgcd', p.astype(vg.dtype), vg).astype(jnp.float32)
        return (o / denom[..., None]).astype(q.dtype)

    out = lax.map(chunk, (qs, ids, vals, poss))
    return jnp.moveaxis(out, 0, 3).reshape(B, Hk, G, T, dh)


def nsa_attention(q, k_cmp, v_cmp, k_sel, v_sel, k_win, v_win, gate_logits, cmp_pe, cmp_w1, cmp_w2):
    B, Hq, T, dh = q.shape
    Hk = k_cmp.shape[1]
    G = Hq // Hk
    scale = dh ** -0.5
    qg = q.reshape(B, Hk, G, T, dh)
    qr = rope(q).reshape(B, Hk, G, T, dh)
    t = jnp.arange(T)
    nc = (T - NSA_CMP_LEN) // NSA_CMP_STRIDE + 1
    starts = jnp.arange(nc) * NSA_CMP_STRIDE
    win = starts[:, None] + jnp.arange(NSA_CMP_LEN)[None, :]

    def compress(z, pe, w1, w2):
        zb = z[:, :, win] + pe
        return jax.nn.gelu(zb.reshape(B, Hk, nc, NSA_CMP_LEN * dh) @ w1) @ w2

    kc = compress(k_cmp, cmp_pe[0], cmp_w1[0], cmp_w2[0])
    vc = compress(v_cmp, cmp_pe[1], cmp_w1[1], cmp_w2[1])
    cmask = (starts + NSA_CMP_LEN - 1)[None, :] <= t[:, None]
    s = jnp.einsum('bhgtd,bhnd->bhgtn', qg, kc).astype(jnp.float32) * scale
    p, _, denom = masked_softmax_stats(s, cmask)
    p_cmp = p / denom[..., None]
    o_cmp = jnp.einsum('bhgtn,bhnd->bhgtd', p_cmp.astype(vc.dtype), vc)
    nsb = T // NSA_SEL_LEN
    sel_start = jnp.arange(nsb) * NSA_SEL_LEN
    overlap = jnp.clip(jnp.minimum((starts + NSA_CMP_LEN)[:, None], (sel_start + NSA_SEL_LEN)[None, :])
                       - jnp.maximum(starts[:, None], sel_start[None, :]), 0, None)
    overlap = overlap.astype(jnp.float32) / NSA_CMP_LEN
    imp = jnp.einsum('bhgtn,nj->bhtj', p_cmp, overlap)
    j = jnp.arange(nsb)[None, :]
    cb = (t // NSA_SEL_LEN)[:, None]
    forced = (j == 0) | (j == cb) | (j == cb - 1)
    score = jnp.where(j <= cb, jnp.where(forced, FORCE_SCORE, imp), NEG_INF)
    top, sel_idx = lax.top_k(score, min(NSA_SEL_COUNT, nsb))
    sel_valid = top > 0.5 * NEG_INF
    ksb = rope(k_sel).reshape(B, Hk, nsb, NSA_SEL_LEN, dh)
    vsb = v_sel.reshape(B, Hk, nsb, NSA_SEL_LEN, dh)
    o_sel = gathered_block_attention(qr, ksb, vsb, sel_idx.astype(jnp.int32), sel_valid)
    o_win, _ = banded_attention(qr, rope(k_win), v_win, NSA_WINDOW - 1)
    g = jax.nn.sigmoid(gate_logits.astype(jnp.float32)).astype(q.dtype)
    g = g.transpose(0, 2, 1, 3).reshape(B, Hk, G, T, 3)
    o = g[..., 0:1] * o_cmp + g[..., 1:2] * o_sel + g[..., 2:3] * o_win
    return o.reshape(B, Hq, T, dh)


def dilated_attention(q, k, v):
    B, H, T, dh = q.shape
    hg = C_HEADS_PER_GROUP
    outs, lses = [], []
    for gi, (w, r) in enumerate(C_GROUPS):
        L = T // r

        def strided(z):
            return z[:, gi * hg:(gi + 1) * hg].reshape(B, hg, L, r, dh).transpose(0, 1, 3, 2, 4).reshape(B, hg * r, L, dh)

        o, lse = banded_attention(strided(q)[:, :, None], strided(k), strided(v), w // r)
        outs.append(o[:, :, 0].reshape(B, hg, r, L, dh).transpose(0, 1, 3, 2, 4).reshape(B, hg, T, dh))
        lses.append(lse[:, :, 0].reshape(B, hg, r, L).transpose(0, 1, 3, 2).reshape(B, hg, T))
    wts = jax.nn.softmax(jnp.stack(lses), axis=0)
    return jnp.einsum('gbht,gbhtd->bhtd', wts.astype(q.dtype), jnp.stack(outs))


def moba_attention(q, k, v):
    B, H, T, dh = q.shape
    nb = -(-T // MOBA_BLOCK)
    padT = nb * MOBA_BLOCK - T
    kb = jnp.pad(k, ((0, 0), (0, 0), (0, padT), (0, 0))).reshape(B, H, nb, MOBA_BLOCK, dh)
    vb = jnp.pad(v, ((0, 0), (0, 0), (0, padT), (0, 0))).reshape(B, H, nb, MOBA_BLOCK, dh)
    cb = (jnp.arange(T) // MOBA_BLOCK).astype(jnp.int32)
    own = jnp.broadcast_to(cb, (B, H, T))[..., None]
    n_sel = min(MOBA_TOPK, nb - 1)
    if n_sel > 0:
        kmean = jnp.mean(kb.astype(jnp.float32), axis=3)
        gate = jnp.einsum('bhtd,bhnd->bhtn', q.astype(jnp.float32), kmean)
        past = jnp.arange(nb)[None, :] < cb[:, None]
        top, sel = lax.top_k(jnp.where(past, gate, NEG_INF), n_sel)
        idx = jnp.concatenate([sel.astype(jnp.int32), own], axis=-1)
        valid = jnp.concatenate([top > 0.5 * NEG_INF, jnp.ones_like(own, dtype=bool)], axis=-1)
    else:
        idx = own
        valid = jnp.ones_like(own, dtype=bool)
    o = gathered_block_attention(q[:, :, None], kb, vb, idx, valid)
    return o[:, :, 0]


def even_mixer(h, w_in, w_out, sinks, cmp_pe, cmp_w1, cmp_w2):
    B, T, _ = h.shape
    aq, ak, av, bq, bkc, bvc, bks, bvs, bkw, bvw, bg = split_cols(h @ w_in, EVEN_SIZES)
    ga = A_Q_HEADS // A_KV_HEADS
    qa = rope(to_heads(aq, A_Q_HEADS)).reshape(B, A_KV_HEADS, ga, T, HEAD_DIM)
    oa, _ = banded_attention(qa, rope(to_heads(ak, A_KV_HEADS)), to_heads(av, A_KV_HEADS),
                             A_WINDOW - 1, sinks.reshape(A_KV_HEADS, ga))
    oa = oa.reshape(B, A_Q_HEADS, T, HEAD_DIM)
    ob = nsa_attention(to_heads(bq, B_Q_HEADS), to_heads(bkc, B_KV_HEADS), to_heads(bvc, B_KV_HEADS),
                       to_heads(bks, B_KV_HEADS), to_heads(bvs, B_KV_HEADS),
                       to_heads(bkw, B_KV_HEADS), to_heads(bvw, B_KV_HEADS),
                       bg.reshape(B, T, B_Q_HEADS, 3), cmp_pe, cmp_w1, cmp_w2)
    return from_heads(jnp.concatenate([oa, ob], axis=1)) @ w_out


def odd_mixer(h, w_in, w_out):
    cq, ck, cv, dq, dk, dv = split_cols(h @ w_in, ODD_SIZES)
    oc = dilated_attention(rope(to_heads(cq, C_HEADS)), rope(to_heads(ck, C_HEADS)), to_heads(cv, C_HEADS))
    od = moba_attention(rope(to_heads(dq, D_HEADS)), rope(to_heads(dk, D_HEADS)), to_heads(dv, D_HEADS))
    return from_heads(jnp.concatenate([oc, od], axis=1)) @ w_out


def setup_inputs(seed: int = 0) -> dict:
    key = jax.random.key(seed)
    ks = jax.random.split(key, 16)
    f32 = jnp.float32

    def normal(k, shape, fan_in):
        return jax.random.normal(k, shape, f32) * fan_in ** -0.5

    def gain(k, shape):
        return 1.0 + 0.05 * jax.random.normal(k, shape, f32)

    return {
        "x": jax.random.normal(ks[0], (BATCH, SEQ, D_MODEL), f32),
        "ffn_norm_pre": gain(ks[1], (DEPTH, D_MODEL)),
        "mix_norm": gain(ks[2], (DEPTH, D_MODEL)),
        "ffn_norm_post": gain(ks[3], (DEPTH, D_MODEL)),
        "ffn_wi": normal(ks[4], (DEPTH, 2, D_MODEL, 2 * D_FF), D_MODEL),
        "ffn_wo": normal(ks[5], (DEPTH, 2, D_FF, D_MODEL), D_FF),
        "even_w_in": normal(ks[6], (N_EVEN, D_MODEL, EVEN_IN), D_MODEL),
        "even_w_out": normal(ks[7], (N_EVEN, EVEN_OUT, D_MODEL), EVEN_OUT),
        "even_sinks": 0.5 * jax.random.normal(ks[8], (N_EVEN, A_Q_HEADS), f32),
        "nsa_cmp_pe": 0.1 * jax.random.normal(ks[9], (N_EVEN, 2, NSA_CMP_LEN, HEAD_DIM), f32),
        "nsa_cmp_w1": normal(ks[10], (N_EVEN, 2, NSA_CMP_LEN * HEAD_DIM, NSA_CMP_HIDDEN), NSA_CMP_LEN * HEAD_DIM),
        "nsa_cmp_w2": normal(ks[11], (N_EVEN, 2, NSA_CMP_HIDDEN, HEAD_DIM), NSA_CMP_HIDDEN),
        "odd_w_in": normal(ks[12], (N_ODD, D_MODEL, ODD_IN), D_MODEL),
        "odd_w_out": normal(ks[13], (N_ODD, ODD_OUT, D_MODEL), ODD_OUT),
        "final_norm": gain(ks[14], (D_MODEL,)),
    }


def reference(x, ffn_norm_pre, mix_norm, ffn_norm_post, ffn_wi, ffn_wo, even_w_in, even_w_out,
              even_sinks, nsa_cmp_pe, nsa_cmp_w1, nsa_cmp_w2, odd_w_in, odd_w_out, final_norm):
    h = x
    for layer in range(DEPTH):
        i = layer // 2
        h = h + 0.5 * swiglu(rms_norm(h, ffn_norm_pre[layer]), ffn_wi[layer, 0], ffn_wo[layer, 0])
        hn = rms_norm(h, mix_norm[layer])
        if layer % 2 == 0:
            h = h + even_mixer(hn, even_w_in[i], even_w_out[i], even_sinks[i],
                               nsa_cmp_pe[i], nsa_cmp_w1[i], nsa_cmp_w2[i])
        else:
            h = h + odd_mixer(hn, odd_w_in[i], odd_w_out[i])
        h = h + 0.5 * swiglu(rms_norm(h, ffn_norm_post[layer]), ffn_wi[layer, 1], ffn_wo[layer, 1])
    return rms_norm(h, final_norm)
```

```cpp
#include <hip/hip_runtime.h>
#include <hip/hip_cooperative_groups.h>
#include <cstdio>
namespace cg = cooperative_groups;

#define LAS __attribute__((address_space(3)))
#define DI __device__ __forceinline__
typedef unsigned short bf16_t;
typedef short bf16x8 __attribute__((ext_vector_type(8)));
typedef short s16x4 __attribute__((ext_vector_type(4)));
typedef float f32x2 __attribute__((ext_vector_type(2)));
typedef float f32x4 __attribute__((ext_vector_type(4)));
typedef float f32x16 __attribute__((ext_vector_type(16)));
typedef unsigned u32x2 __attribute__((ext_vector_type(2)));
typedef unsigned u32x4 __attribute__((ext_vector_type(4)));
typedef __bf16 bf2_t __attribute__((ext_vector_type(2)));

DI unsigned pk2(float a, float b) { f32x2 v = {a, b}; bf2_t r = __builtin_convertvector(v, bf2_t); return __builtin_bit_cast(unsigned, r); }
DI float bf2f(bf16_t v) { return __uint_as_float(((unsigned)v) << 16); }
DI bf16_t f2bf(float f) { return (bf16_t)(pk2(f, 0.f) & 0xffffu); }
DI unsigned char* launder(unsigned char* p) { size_t z = 0; asm volatile("" : "+s"(z)); return p + z; }
#define MFMA32(a, b, c) __builtin_amdgcn_mfma_f32_32x32x16_bf16((a), (b), (c), 0, 0, 0)

constexpr int T = 4096, NTOK = 32768, DM = 1024, DFF = 2816;
constexpr float EPS = 1e-6f;
constexpr size_t MiB = 1048576;

constexpr size_t OFF_HB = 0;
constexpr size_t OFF_SS = OFF_HB + 64 * MiB;
constexpr size_t OFF_ROPE = OFF_SS + (size_t)7 * 32768 * 16 * 4;
constexpr size_t OFF_CBIAS = OFF_ROPE + 4096 * 32 * 8;
constexpr size_t OFF_SINK = OFF_CBIAS + 2048;
constexpr size_t OFF_FNG = OFF_CBIAS + 4096;
constexpr size_t OFF_WI = OFF_FNG + 4096;
constexpr size_t OFF_WO = OFF_WI + (size_t)4 * 5632 * 1024 * 2;
constexpr size_t OFF_EWIN = OFF_WO + (size_t)4 * 1024 * 2816 * 2;
constexpr size_t OFF_EWOUT = OFF_EWIN + (size_t)2304 * 1024 * 2;
constexpr size_t OFF_OWIN = OFF_EWOUT + (size_t)1024 * 1024 * 2;
constexpr size_t OFF_OWOUT = OFF_OWIN + (size_t)3072 * 1024 * 2;
constexpr size_t OFF_CW1 = OFF_OWOUT + (size_t)1024 * 512 * 2;
constexpr size_t OFF_CW2 = OFF_CW1 + (size_t)2 * 256 * 2048 * 2;
constexpr size_t OFF_BAR = OFF_CW2 + (size_t)2 * 256 * 256 * 2;
constexpr size_t OFF_SCR = OFF_BAR + 16384;
constexpr size_t OFF_ACT = OFF_SCR;
constexpr size_t OFF_QA = OFF_SCR;
constexpr size_t OFF_KA = OFF_QA + 32 * MiB;
constexpr size_t OFF_VTA = OFF_KA + 8 * MiB;
constexpr size_t OFF_QBG = OFF_VTA + 8 * MiB;
constexpr size_t OFF_QBR = OFF_QBG + 32 * MiB;
constexpr size_t OFF_KCIN = OFF_QBR + 32 * MiB;
constexpr size_t OFF_VCIN = OFF_KCIN + 8 * MiB;
constexpr size_t OFF_KS = OFF_VCIN + 8 * MiB + 65536;
constexpr size_t OFF_VTS = OFF_KS + 8 * MiB;
constexpr size_t OFF_KW = OFF_VTS + 8 * MiB;
constexpr size_t OFF_VTW = OFF_KW + 8 * MiB;
constexpr size_t OFF_GATE = OFF_VTW + 8 * MiB;
constexpr size_t OFF_HID = OFF_GATE + 3 * MiB;
constexpr size_t OFF_KC = OFF_HID + 4 * MiB;
constexpr size_t OFF_VTC = OFF_KC + 524288;
constexpr size_t OFF_MIX = OFF_VTC + 524288;
constexpr size_t END_EVEN = OFF_MIX + 64 * MiB;
constexpr size_t OFF_CQ = OFF_SCR;
constexpr size_t OFF_CK = OFF_CQ + 48 * MiB;
constexpr size_t OFF_VTCD = OFF_CK + 48 * MiB;
constexpr size_t OFF_DQ = OFF_VTCD + 48 * MiB;
constexpr size_t OFF_DK = OFF_DQ + 16 * MiB;
constexpr size_t OFF_VTD = OFF_DK + 16 * MiB;
constexpr size_t OFF_KMEAN = OFF_VTD + 16 * MiB;
constexpr size_t OFF_MIX2 = OFF_KMEAN + 131072;
constexpr size_t OFF_OG = OFF_MIX2 + 32 * MiB;
constexpr size_t OFF_LSEG = OFF_OG + 48 * MiB;
constexpr size_t END_ODD = OFF_LSEG + (size_t)3 * 32768 * 4 * 4;
constexpr size_t WS_END = END_EVEN > END_ODD ? END_EVEN : END_ODD;

struct Params {
    const float* in[15];
    float* out;
    unsigned char* ws;
    int ph_lo, ph_hi, coop, pad;
};

namespace pg8 {
constexpr int BM = 256, BK = 64, HALF = 128, HTB = HALF * BK * 2, STAGE_BYTES = 8 * HTB, NXCD = 8, WGM = 4;
__host__ __device__ __forceinline__ int lds_byte(int r, int c) { const int st = (r >> 4) * 2 + (c >> 5), rr = r & 15, cc = c & 31, ob = rr * 64 + cc * 2; return st * 1024 + (ob ^ (((ob >> 9) & 1) << 5)); }
__host__ __device__ __forceinline__ void stage_rc(int b, int& R, int& C) { const int st = b / 1024, sb = b % 1024, swz = sb ^ (((sb >> 9) & 1) << 5); R = (st >> 1) * 16 + swz / 64; C = (st & 1) * 32 + (swz % 64) / 2; }
struct Unit { int pm, pn; };
struct Gemm { const bf16_t* A; const bf16_t* Bt; int M, N, K, lda; };
struct StaticOrder {
    int nM, nN, nwg, G, c;
    __device__ void init(int M, int N, int G_, int c_) { nM = M / BM; nN = N / BM; nwg = nM * nN; G = G_; c = c_; }
    __device__ bool next(int i, Unit& u) const {
        const long L = (long)i * G + c; if (L >= nwg) return false;
        int wgid = (int)L; { const int q = nwg / NXCD, r = nwg % NXCD, xcd = wgid % NXCD, off = wgid / NXCD; wgid = (xcd < r ? xcd * (q + 1) : r * (q + 1) + (xcd - r) * q) + off; }
        const int nig = WGM * nN, gid = wgid / nig, fm = gid * WGM, gsz = (nM - fm) < WGM ? (nM - fm) : WGM;
        u.pm = fm + ((wgid % nig) % gsz); u.pn = (wgid % nig) / gsz; return true;
    }
};
struct OneUnit { int pm, pn; __device__ bool next(int i, Unit& u) const { if (i > 0) return false; u.pm = pm; u.pn = pn; return true; } };
template <class Epi, class Sched>
DI void gemm_phase(LAS unsigned char* lds, const Gemm g, const Sched& S, const Epi& E) {
    int tid = threadIdx.x; asm volatile("" : "+v"(tid));
    const int wid = __builtin_amdgcn_readfirstlane(tid >> 6), lane = tid & 63, wr = wid >> 2, wc = wid & 3, fr = lane & 15, fq = lane >> 4;
    const int K = g.K, nt = K / BK, lda = g.lda;
    unsigned voffA[2], voffB[2];
#pragma unroll
    for (int i = 0; i < 2; ++i) { int R, C; stage_rc(tid * 16 + i * 8192, R, C);
        voffA[i] = (unsigned)(R * lda + C) * 2u; voffB[i] = (unsigned)(R * K + C) * 2u; }
    const size_t kstep = (size_t)(BK * 2);
    const size_t hstepA = (size_t)HALF * lda * 2, hstepB = (size_t)HALF * K * 2;
    const size_t tstepA = 2 * hstepA, tstepB = 2 * hstepB;
    const unsigned ldsw = (unsigned)wid * 1024u;
    const int aoff = lds_byte(wr * 64 + fr, fq * 8), boff = lds_byte(wc * 32 + fr, fq * 8);
#define PG8_SA(b, h) (((b) * 2 + (h)) * HTB)
#define PG8_SB(b, h) ((4 + (b) * 2 + (h)) * HTB)
#define PG8_STAGE(bufoff, gbase, voff) do { _Pragma("unroll") for (int _i = 0; _i < 2; ++_i) \
        __builtin_amdgcn_global_load_lds((const unsigned*)((const char*)(gbase) + (voff)[_i]), (LAS unsigned*)(lds + (bufoff) + ldsw + _i * 8192), 16, 0, 0); } while (0)
#define PG8_LDA(dst, b, h) do { _Pragma("unroll") for (int m = 0; m < 4; ++m) _Pragma("unroll") for (int k = 0; k < 2; ++k) dst[m][k] = *(const LAS bf16x8*)(lds + PG8_SA(b, h) + aoff + m * 2048 + k * 1024); } while (0)
#define PG8_LDB(dst, b, h) do { _Pragma("unroll") for (int n = 0; n < 2; ++n) _Pragma("unroll") for (int k = 0; k < 2; ++k) dst[n][k] = *(const LAS bf16x8*)(lds + PG8_SB(b, h) + boff + n * 2048 + k * 1024); } while (0)
#define PG8_MMA(ai, bj, At, Bt) do { __builtin_amdgcn_s_setprio(1); _Pragma("unroll") for (int m = 0; m < 4; ++m) _Pragma("unroll") for (int n = 0; n < 2; ++n) _Pragma("unroll") for (int k = 0; k < 2; ++k) \
        acc[ai][bj][m][n] = __builtin_amdgcn_mfma_f32_16x16x32_bf16(Bt[n][k], At[m][k], acc[ai][bj][m][n], 0, 0, 0); __builtin_amdgcn_s_setprio(0); } while (0)
#define PG8_WAIT_V(n) asm volatile("s_waitcnt vmcnt(" #n ")" ::: "memory")
#define PG8_WAIT_L(n) asm volatile("s_waitcnt lgkmcnt(" #n ")" ::: "memory")
#define PG8_BAR __builtin_amdgcn_s_barrier()
#define PG8_SCHED __builtin_amdgcn_sched_barrier(0)
    Unit cur, nxt; int ui = 0;
    if (!S.next(0, cur)) return;
    f32x4 acc[2][2][4][2];
#pragma unroll
    for (int a = 0; a < 2; ++a)
#pragma unroll
        for (int b = 0; b < 2; ++b)
#pragma unroll
            for (int m = 0; m < 4; ++m)
#pragma unroll
                for (int n = 0; n < 2; ++n) acc[a][b][m][n] = (f32x4){0.f, 0.f, 0.f, 0.f};
    bf16x8 At[4][2], B0[2][2], B1[2][2];
    const char* cA = (const char*)g.A + (size_t)cur.pm * tstepA; const char* cB = (const char*)g.Bt + (size_t)cur.pn * tstepB;
    PG8_STAGE(PG8_SB(0, 0), cB, voffB); PG8_STAGE(PG8_SA(0, 0), cA, voffA); PG8_STAGE(PG8_SB(0, 1), cB + hstepB, voffB); PG8_STAGE(PG8_SA(0, 1), cA + hstepA, voffA);
    if (wr == 1) PG8_BAR;
    PG8_WAIT_V(4); PG8_BAR;
    PG8_STAGE(PG8_SB(1, 0), cB + kstep, voffB); PG8_STAGE(PG8_SA(1, 0), cA + kstep, voffA); PG8_STAGE(PG8_SB(1, 1), cB + hstepB + kstep, voffB);
    PG8_WAIT_V(6); PG8_BAR;
    for (;;) {
        const bool has_next = S.next(ui + 1, nxt);
        const char* nA = has_next ? (const char*)g.A + (size_t)nxt.pm * tstepA : cA; const char* nB = has_next ? (const char*)g.Bt + (size_t)nxt.pn * tstepB : cB;
        for (int t = 0; t < nt; t += 2) {
            const bool last = (t == nt - 2);
            const char* a1 = cA + (size_t)(t + 1) * kstep;
            const char* a2 = last ? nA : cA + (size_t)(t + 2) * kstep; const char* b2 = last ? nB : cB + (size_t)(t + 2) * kstep;
            const char* a3 = a2 + kstep; const char* b3 = b2 + kstep;
            PG8_LDB(B0, 0, 0); PG8_SCHED; PG8_LDA(At, 0, 0); PG8_STAGE(PG8_SA(1, 1), a1 + hstepA, voffA);
            PG8_WAIT_L(8); PG8_BAR; PG8_WAIT_L(0); PG8_MMA(0, 0, At, B0); PG8_BAR; PG8_SCHED;
            PG8_LDB(B1, 0, 1); PG8_STAGE(PG8_SB(0, 0), b2, voffB);
            PG8_BAR; PG8_WAIT_L(0); PG8_MMA(0, 1, At, B1); PG8_BAR;
            PG8_LDA(At, 0, 1); PG8_STAGE(PG8_SA(0, 0), a2, voffA);
            PG8_BAR; PG8_WAIT_L(0); PG8_MMA(1, 0, At, B0); PG8_BAR; PG8_SCHED;
            PG8_STAGE(PG8_SB(0, 1), b2 + hstepB, voffB);
            PG8_WAIT_V(6); PG8_BAR; PG8_MMA(1, 1, At, B1); PG8_BAR;
            PG8_LDB(B0, 1, 0); PG8_SCHED; PG8_LDA(At, 1, 0); PG8_STAGE(PG8_SA(0, 1), a2 + hstepA, voffA);
            PG8_WAIT_L(8); PG8_BAR; PG8_WAIT_L(0); PG8_MMA(0, 0, At, B0); PG8_BAR; PG8_SCHED;
            PG8_LDB(B1, 1, 1); PG8_STAGE(PG8_SB(1, 0), b3, voffB);
            PG8_BAR; PG8_WAIT_L(0); PG8_MMA(0, 1, At, B1); PG8_BAR;
            PG8_LDA(At, 1, 1); PG8_STAGE(PG8_SA(1, 0), a3, voffA);
            PG8_BAR; PG8_WAIT_L(0); PG8_MMA(1, 0, At, B0); PG8_BAR; PG8_SCHED;
            PG8_STAGE(PG8_SB(1, 1), b3 + hstepB, voffB);
            PG8_WAIT_V(6); PG8_BAR; PG8_MMA(1, 1, At, B1); PG8_BAR;
        }
        E(acc, cur, wr, wc, fr, fq);
        if (!has_next) break;
#pragma unroll
        for (int a = 0; a < 2; ++a)
#pragma unroll
            for (int b = 0; b < 2; ++b)
#pragma unroll
                for (int m = 0; m < 4; ++m)
#pragma unroll
                    for (int n = 0; n < 2; ++n) acc[a][b][m][n] = (f32x4){0.f, 0.f, 0.f, 0.f};
        cur = nxt; cA = nA; cB = nB; ++ui;
    }
    PG8_WAIT_V(0);
    if (wr == 0) PG8_BAR;
    PG8_BAR;
#undef PG8_SA
#undef PG8_SB
#undef PG8_STAGE
#undef PG8_LDA
#undef PG8_LDB
#undef PG8_MMA
#undef PG8_WAIT_V
#undef PG8_WAIT_L
#undef PG8_BAR
#undef PG8_SCHED
}
}
using pg8::Unit;
typedef f32x4 AccT[2][2][4][2];

DI float row_rs(const float* ss, int row) {
    const f32x4* q = (const f32x4*)(ss + (size_t)row * 16);
    const f32x4 a = q[0], b = q[1], c = q[2], d = q[3];
    const float s = ((a[0] + a[1]) + (a[2] + a[3])) + ((b[0] + b[1]) + (b[2] + b[3])) + ((c[0] + c[1]) + (c[2] + c[3])) + ((d[0] + d[1]) + (d[2] + d[3]));
    return rsqrtf(s * (1.0f / 1024.0f) + EPS);
}
struct EpiSwiglu {
    const float* ss; bf16_t* act;
    DI void operator()(const AccT& acc, const Unit& u, int wr, int wc, int fr, int fq) const {
        const int lane = fq * 16 + fr;
        float rsv[2];
#pragma unroll
        for (int ai = 0; ai < 2; ++ai) rsv[ai] = row_rs(ss, u.pm * 256 + ai * 128 + wr * 64 + lane);
#pragma unroll
        for (int ai = 0; ai < 2; ++ai)
#pragma unroll
            for (int m = 0; m < 4; ++m) {
                const int row = u.pm * 256 + ai * 128 + wr * 64 + m * 16 + fr;
                const float rs = __shfl(rsv[ai], m * 16 + fr);
                float a[8];
#pragma unroll
                for (int n = 0; n < 2; ++n)
#pragma unroll
                    for (int j = 0; j < 4; ++j) {
                        const float gt = acc[ai][0][m][n][j] * rs, up = acc[ai][1][m][n][j] * rs;
                        a[n * 4 + j] = gt * up * __builtin_amdgcn_rcpf(1.0f + __builtin_amdgcn_exp2f(gt * -1.4426950408889634f));
                    }
                u32x4 pk = {pk2(a[0], a[1]), pk2(a[2], a[3]), pk2(a[4], a[5]), pk2(a[6], a[7])};
                *(u32x4*)(act + (size_t)row * DFF + u.pn * 128 + wc * 32 + fq * 8) = pk;
            }
    }
};
struct EpiResid {
    const float* xin; bf16_t* hb; float* ssn; float scale;
    DI void operator()(const AccT& acc, const Unit& u, int wr, int wc, int fr, int fq) const {
#pragma unroll
        for (int ai = 0; ai < 2; ++ai) {
            float sq[4] = {0.f, 0.f, 0.f, 0.f};
            const int rowb = u.pm * 256 + ai * 128 + wr * 64 + fr;
#pragma unroll
            for (int bj = 0; bj < 2; ++bj) {
                const size_t ob = (size_t)rowb * DM + u.pn * 256 + bj * 128 + wc * 32 + fq * 8;
                f32x4 v0[4], v1[4];
                if (xin) {
#pragma unroll
                    for (int m = 0; m < 4; ++m) { v0[m] = __builtin_nontemporal_load((const f32x4*)(xin + ob + (size_t)m * 16 * DM)); v1[m] = __builtin_nontemporal_load((const f32x4*)(xin + ob + (size_t)m * 16 * DM + 4)); }
                } else {
                    u32x4 q[4];
#pragma unroll
                    for (int m = 0; m < 4; ++m) q[m] = *(const u32x4*)(hb + ob + (size_t)m * 16 * DM);
#pragma unroll
                    for (int m = 0; m < 4; ++m) {
                        v0[m] = (f32x4){__uint_as_float(q[m][0] << 16), __uint_as_float(q[m][0] & 0xffff0000u), __uint_as_float(q[m][1] << 16), __uint_as_float(q[m][1] & 0xffff0000u)};
                        v1[m] = (f32x4){__uint_as_float(q[m][2] << 16), __uint_as_float(q[m][2] & 0xffff0000u), __uint_as_float(q[m][3] << 16), __uint_as_float(q[m][3] & 0xffff0000u)};
                    }
                }
#pragma unroll
                for (int m = 0; m < 4; ++m) {
                    const f32x4 a0 = v0[m] + acc[ai][bj][m][0] * scale, a1 = v1[m] + acc[ai][bj][m][1] * scale;
                    *(u32x4*)(hb + ob + (size_t)m * 16 * DM) = (u32x4){pk2(a0[0], a0[1]), pk2(a0[2], a0[3]), pk2(a1[0], a1[1]), pk2(a1[2], a1[3])};
                    sq[m] += a0[0] * a0[0] + a0[1] * a0[1] + a0[2] * a0[2] + a0[3] * a0[3] + a1[0] * a1[0] + a1[1] * a1[1] + a1[2] * a1[2] + a1[3] * a1[3];
                }
            }
#pragma unroll
            for (int m = 0; m < 4; ++m) {
                float t = sq[m];
                t += __shfl_xor(t, 16);
                t += __shfl_xor(t, 32);
                if (fq == 0) ssn[(size_t)(rowb + m * 16) * 16 + u.pn * 4 + wc] = t;
            }
        }
    }
};
enum { GK_SKIP = 0, GK_PLAIN = 1, GK_ROPE = 2, GK_BOTH = 3, GK_VT = 4, GK_GATE = 5 };
struct GroupDesc { int kind; size_t off, off2; int nh, hd; };
DI GroupDesc even_desc(int G) {
    GroupDesc d; d.kind = GK_SKIP; d.off = 0; d.off2 = 0; d.nh = 2; d.hd = 0;
    if (G < 8) { d.kind = GK_ROPE; d.off = OFF_QA; d.nh = 8; d.hd = G; }
    else if (G < 10) { d.kind = GK_ROPE; d.off = OFF_KA; d.hd = G - 8; }
    else if (G < 12) { d.kind = GK_VT; d.off = OFF_VTA; d.hd = G - 10; }
    else if (G < 20) { d.kind = GK_BOTH; d.off = OFF_QBG; d.off2 = OFF_QBR; d.nh = 8; d.hd = G - 12; }
    else if (G < 22) { d.kind = GK_PLAIN; d.off = OFF_KCIN; d.hd = G - 20; }
    else if (G < 24) { d.kind = GK_PLAIN; d.off = OFF_VCIN; d.hd = G - 22; }
    else if (G < 26) { d.kind = GK_ROPE; d.off = OFF_KS; d.hd = G - 24; }
    else if (G < 28) { d.kind = GK_VT; d.off = OFF_VTS; d.hd = G - 26; }
    else if (G < 30) { d.kind = GK_ROPE; d.off = OFF_KW; d.hd = G - 28; }
    else if (G < 32) { d.kind = GK_VT; d.off = OFF_VTW; d.hd = G - 30; }
    else if (G == 32) { d.kind = GK_GATE; d.off = OFF_GATE; }
    return d;
}
DI GroupDesc odd_desc(int G) {
    GroupDesc d; d.kind = GK_SKIP; d.off = 0; d.off2 = 0; d.nh = 12; d.hd = 0;
    if (G < 12) { d.kind = GK_ROPE; d.off = OFF_CQ; d.hd = G; }
    else if (G < 24) { d.kind = GK_ROPE; d.off = OFF_CK; d.hd = G - 12; }
    else if (G < 36) { d.kind = GK_VT; d.off = OFF_VTCD; d.hd = G - 24; }
    else if (G < 40) { d.kind = GK_ROPE; d.off = OFF_DQ; d.nh = 4; d.hd = G - 36; }
    else if (G < 44) { d.kind = GK_ROPE; d.off = OFF_DK; d.nh = 4; d.hd = G - 40; }
    else { d.kind = GK_VT; d.off = OFF_VTD; d.nh = 4; d.hd = G - 44; }
    return d;
}
struct EpiWin {
    const float* ss; unsigned char* ws; int odd; LAS unsigned char* tl;
    DI void operator()(const AccT& acc, const Unit& u, int wr, int wc, int fr, int fq) const {
        const int G = u.pn * 4 + wc;
        const GroupDesc d = odd ? odd_desc(G) : even_desc(G);
        if (d.kind == GK_SKIP) return;
        const f32x4* rope = (const f32x4*)(ws + OFF_ROPE);
        const int sh = (d.kind == GK_VT && odd && d.nh == 12) ? (d.hd >= 8 ? 4 : (d.hd >= 4 ? 2 : 0)) : 0;
        if (d.kind == GK_VT && sh != 4) {
            LAS unsigned char* wl = tl + (wr * 4 + wc) * 2048;
            const int lane = fq * 16 + fr, dimr = lane >> 1, c0 = 2 * (lane & 1);
            float rsw[2];
#pragma unroll
            for (int ai = 0; ai < 2; ++ai) rsw[ai] = row_rs(ss, u.pm * 256 + ai * 128 + wr * 64 + lane);
#pragma unroll
            for (int ai = 0; ai < 2; ++ai)
#pragma unroll
                for (int mp = 0; mp < 2; ++mp) {
                    const int row0 = u.pm * 256 + ai * 128 + wr * 64 + 32 * mp;
                    const int b = row0 >> 12, t0 = row0 & 4095;
                    const float rsa = __shfl(rsw[ai], 32 * mp + fr), rsb = __shfl(rsw[ai], 32 * mp + 16 + fr);
                    bf16_t* vb = (bf16_t*)(ws + d.off) + (size_t)(b * d.nh + d.hd) * 64 * T;
#pragma unroll
                    for (int hf = 0; hf < 2; ++hf) {
#pragma unroll
                        for (int mm = 0; mm < 2; ++mm) {
                            const int tlo = 16 * mm + fr;
                            const int col = sh == 0 ? tlo : ((tlo & 3) * 8 + (tlo >> 2));
                            const float rs = mm ? rsb : rsa;
#pragma unroll
                            for (int n = 0; n < 2; ++n)
#pragma unroll
                                for (int j = 0; j < 4; ++j)
                                    *(LAS bf16_t*)(wl + ((8 * fq + 4 * n + j) * 32 + col) * 2) = f2bf(acc[ai][hf][2 * mp + mm][n][j] * rs);
                        }
#pragma unroll
                        for (int cc = 0; cc < 2; ++cc) {
                            const int c = c0 + cc;
                            const u32x4 v = *(LAS const u32x4*)(wl + (dimr * 32 + c * 8) * 2);
                            const int pos = sh == 0 ? (t0 + 8 * c) : (c * 1024 + (t0 >> 2));
                            *(u32x4*)(vb + (size_t)(32 * hf + dimr) * T + pos) = v;
                        }
                    }
                }
            return;
        }
        float rsv[2];
#pragma unroll
        for (int ai = 0; ai < 2; ++ai) rsv[ai] = row_rs(ss, u.pm * 256 + ai * 128 + wr * 64 + fq * 16 + fr);
        f32x4 csb[4], rot[4];
        const bool roped = d.kind == GK_ROPE || d.kind == GK_BOTH;
        if (roped) {
#pragma unroll
            for (int e2 = 0; e2 < 4; ++e2) rot[e2] = rope[((size_t)16 * 32 + fq * 8) / 2 + e2];
        }
#pragma unroll
        for (int ai = 0; ai < 2; ++ai) {
            if (roped) {
                const int tb0 = (u.pm * 256 + ai * 128 + wr * 64 + fr) & 4095;
#pragma unroll
                for (int e2 = 0; e2 < 4; ++e2) csb[e2] = rope[((size_t)tb0 * 32 + fq * 8) / 2 + e2];
            }
#pragma unroll
            for (int m = 0; m < 4; ++m) {
                const int row = u.pm * 256 + ai * 128 + wr * 64 + m * 16 + fr;
                const int b = row >> 12, t = row & 4095;
                const float rs = __shfl(rsv[ai], m * 16 + fr);
                float x1[8], x2[8];
#pragma unroll
                for (int n = 0; n < 2; ++n)
#pragma unroll
                    for (int j = 0; j < 4; ++j) { x1[n * 4 + j] = acc[ai][0][m][n][j] * rs; x2[n * 4 + j] = acc[ai][1][m][n][j] * rs; }
                if (d.kind == GK_GATE) {
                    if (fq < 3) {
                        float* gp = (float*)(ws + d.off) + (size_t)row * 24 + fq * 8;
                        float sg[8];
#pragma unroll
                        for (int e = 0; e < 8; ++e) sg[e] = __builtin_amdgcn_rcpf(1.0f + __builtin_amdgcn_exp2f(x1[e] * -1.4426950408889634f));
                        *(f32x4*)gp = (f32x4){sg[0], sg[1], sg[2], sg[3]};
                        *(f32x4*)(gp + 4) = (f32x4){sg[4], sg[5], sg[6], sg[7]};
                    }
                } else if (d.kind == GK_VT) {
                    const int tp = ((t & 15) << 8) + (t >> 4);
                    bf16_t* vp = (bf16_t*)(ws + d.off) + ((size_t)(b * d.nh + d.hd) * 64 + fq * 8) * T + tp;
#pragma unroll
                    for (int e = 0; e < 8; ++e) { vp[(size_t)e * T] = f2bf(x1[e]); vp[(size_t)(32 + e) * T] = f2bf(x2[e]); }
                } else {
                    const size_t ro = ((size_t)(b * d.nh + d.hd) * T + t) * 64 + fq * 8;
                    if (d.kind == GK_PLAIN || d.kind == GK_BOTH) {
                        bf16_t* dp = (bf16_t*)(ws + d.off) + ro;
                        *(u32x4*)dp = (u32x4){pk2(x1[0], x1[1]), pk2(x1[2], x1[3]), pk2(x1[4], x1[5]), pk2(x1[6], x1[7])};
                        *(u32x4*)(dp + 32) = (u32x4){pk2(x2[0], x2[1]), pk2(x2[2], x2[3]), pk2(x2[4], x2[5]), pk2(x2[6], x2[7])};
                    }
                    if (d.kind == GK_ROPE || d.kind == GK_BOTH) {
                        bf16_t* dp = (bf16_t*)(ws + (d.kind == GK_BOTH ? d.off2 : d.off)) + ro;
                        float y1[8], y2[8];
#pragma unroll
                        for (int e2 = 0; e2 < 4; ++e2) {
                            const f32x4 cs = csb[e2];
                            y1[2 * e2] = x1[2 * e2] * cs[0] - x2[2 * e2] * cs[1];       y2[2 * e2] = x2[2 * e2] * cs[0] + x1[2 * e2] * cs[1];
                            y1[2 * e2 + 1] = x1[2 * e2 + 1] * cs[2] - x2[2 * e2 + 1] * cs[3]; y2[2 * e2 + 1] = x2[2 * e2 + 1] * cs[2] + x1[2 * e2 + 1] * cs[3];
                        }
                        *(u32x4*)dp = (u32x4){pk2(y1[0], y1[1]), pk2(y1[2], y1[3]), pk2(y1[4], y1[5]), pk2(y1[6], y1[7])};
                        *(u32x4*)(dp + 32) = (u32x4){pk2(y2[0], y2[1]), pk2(y2[2], y2[3]), pk2(y2[4], y2[5]), pk2(y2[6], y2[7])};
                        if (m < 3) {
#pragma unroll
                            for (int e2 = 0; e2 < 4; ++e2) {
                                const f32x4 c = csb[e2], q = rot[e2];
                                csb[e2] = (f32x4){c[0] * q[0] - c[1] * q[1], c[1] * q[0] + c[0] * q[1], c[2] * q[2] - c[3] * q[3], c[3] * q[2] + c[2] * q[3]};
                            }
                        }
                    }
                }
            }
        }
    }
};
DI float gelu_tanh(float x) {
    const float u = 0.7978845608028654f * (x + 0.044715f * x * x * x);
    const float th = 1.0f - 2.0f / (__expf(2.0f * u) + 1.0f);
    return 0.5f * x * (1.0f + th);
}
struct EpiCmp1 {
    const float* cbias; bf16_t* hid;
    DI void operator()(const AccT& acc, const Unit& u, int wr, int wc, int fr, int fq) const {
        f32x4 cbv[2][2];
#pragma unroll
        for (int bj = 0; bj < 2; ++bj)
#pragma unroll
            for (int n = 0; n < 2; ++n) cbv[bj][n] = *(const f32x4*)(cbias + bj * 128 + wc * 32 + n * 16 + fq * 4);
#pragma unroll
        for (int ai = 0; ai < 2; ++ai)
#pragma unroll
            for (int m = 0; m < 4; ++m) {
                const int row = u.pm * 256 + ai * 128 + wr * 64 + m * 16 + fr;
#pragma unroll
                for (int bj = 0; bj < 2; ++bj)
#pragma unroll
                    for (int n = 0; n < 2; ++n) {
                        const int col = bj * 128 + wc * 32 + n * 16 + fq * 4;
                        const f32x4 v = acc[ai][bj][m][n] + cbv[bj][n];
                        u32x2 pk = {pk2(gelu_tanh(v[0]), gelu_tanh(v[1])), pk2(gelu_tanh(v[2]), gelu_tanh(v[3]))};
                        *(u32x2*)(hid + (size_t)row * 256 + col) = pk;
                    }
            }
    }
};
struct EpiCmp2 {
    unsigned char* ws; int kv;
    DI void operator()(const AccT& acc, const Unit& u, int wr, int wc, int fr, int fq) const {
        if (wc >= 2) return;
#pragma unroll
        for (int ai = 0; ai < 2; ++ai)
#pragma unroll
            for (int m = 0; m < 4; ++m) {
                const int nidx = ai * 128 + wr * 64 + m * 16 + fr;
                const float z = (nidx == 255) ? 0.f : 1.f;
#pragma unroll
                for (int n = 0; n < 2; ++n) {
                    const int col = wc * 32 + n * 16 + fq * 4;
                    const f32x4 v = acc[ai][0][m][n] * z;
                    if (kv == 0) {
                        u32x2 pk = {pk2(v[0], v[1]), pk2(v[2], v[3])};
                        *(u32x2*)((bf16_t*)(ws + OFF_KC) + ((size_t)u.pm * 256 + nidx) * 64 + col) = pk;
                    } else {
                        bf16_t* vp = (bf16_t*)(ws + OFF_VTC) + ((size_t)u.pm * 64 + col) * 256 + nidx;
#pragma unroll
                        for (int j = 0; j < 4; ++j) vp[j * 256] = f2bf(v[j]);
                    }
                }
            }
    }
};

struct AState { f32x16 o0, o1; float m, l; };
DI f32x16 zero16() { f32x16 z; for (int i = 0; i < 16; ++i) z[i] = 0.f; return z; }
DI void astate_init(AState& s) { s.o0 = zero16(); s.o1 = zero16(); s.m = -1e29f; s.l = 0.f; }
DI void load_q(bf16x8 (&qf)[4], const bf16_t* qrow, int h) {
#pragma unroll
    for (int i = 0; i < 4; ++i) qf[i] = __builtin_nontemporal_load((const bf16x8*)(qrow + 8 * h + 16 * i));
}
constexpr int LDS_KROW = 144, LDS_VROW = 528, LDS_VOFF = 256 * 144;
constexpr float LOG2E = 1.4426950408889634f, LN2 = 0.6931471805599453f;
constexpr float SCL2 = 0.125f * LOG2E;
constexpr int LDS_ABUF = 256 * 144 + 64 * 528;
template <int AUX = 0>
DI void stage_dma(LAS unsigned char* buf, const bf16_t* Kg, const bf16_t* Vtg, int vts, int kb0, int nkeys, int wid, int lane, int kstride = 1, int koff = 0) {
    const int lrow = (lane * 57) >> 9, lpart = lane - lrow * 9;
    const int lp8 = (lpart < 8 ? lpart : 7) * 8;
    const int ninstr = (nkeys + 6) / 7;
    for (int k = wid; k < ninstr; k += 8) {
        const int row = 7 * k + lrow;
        if (lane < 63 && row < nkeys) {
            const bf16_t* src = Kg + (size_t)(koff + kstride * (kb0 + row)) * 64 + lp8;
            __builtin_amdgcn_global_load_lds((const unsigned*)src, (LAS unsigned*)(buf + k * (7 * LDS_KROW)), 16, 0, AUX);
        }
    }
    for (int g0 = wid * 64; g0 < 2112; g0 += 512) {
        const int g = g0 + lane;
        const int dim = g / 33, part = g - dim * 33;
        const bf16_t* src = Vtg + (size_t)dim * vts + kb0 + (part < 32 ? part : 31) * 8;
        __builtin_amdgcn_global_load_lds((const unsigned*)src, (LAS unsigned*)(buf + LDS_VOFF + g0 * 16), 16, 0, AUX);
    }
}
DI float xmax32(float x) {
    auto pr = __builtin_amdgcn_permlane32_swap(__float_as_uint(x), __float_as_uint(x), false, false);
    return fmaxf(__uint_as_float(pr[0]), __uint_as_float(pr[1]));
}
DI float xother32(float x, int h) {
    auto pr = __builtin_amdgcn_permlane32_swap(__float_as_uint(x), __float_as_uint(x), false, false);
    return __uint_as_float(h == 0 ? pr[1] : pr[0]);
}
DI int xother32i(int x, int h) {
    auto pr = __builtin_amdgcn_permlane32_swap((unsigned)x, (unsigned)x, false, false);
    return (int)(h == 0 ? pr[1] : pr[0]);
}
DI float quad_sum(float x) {
    x += __uint_as_float(__builtin_amdgcn_update_dpp(0u, __float_as_uint(x), 0xB1, 0xF, 0xF, true));
    x += __uint_as_float(__builtin_amdgcn_update_dpp(0u, __float_as_uint(x), 0x4E, 0xF, 0xF, true));
    return x;
}
DI f32x16 qk_tile_lds(const bf16x8 (&qf)[4], LAS const unsigned char* lds, int ti, int r, int h) {
    LAS const unsigned char* kp = lds + (ti * 32 + r) * LDS_KROW + h * 16;
    bf16x8 kf[4];
#pragma unroll
    for (int i = 0; i < 4; ++i) kf[i] = *(LAS const bf16x8*)(kp + 32 * i);
    f32x16 sc = zero16();
#pragma unroll
    for (int i = 0; i < 4; ++i) sc = MFMA32(kf[i], qf[i], sc);
    return sc;
}
template <bool KEYMASK, class MaskF>
DI void attn_tile(AState& st, const bf16x8 (&qf)[4], LAS const unsigned char* lds, int ti, int kb, int r, int h, bool lane_ok, const MaskF& mask) {
    LAS const unsigned char* kp = lds + (ti * 32 + r) * LDS_KROW + h * 16;
    bf16x8 kf[4];
#pragma unroll
    for (int i = 0; i < 4; ++i) kf[i] = *(LAS const bf16x8*)(kp + 32 * i);
    LAS const unsigned char* vp = lds + LDS_VOFF + r * LDS_VROW + (ti * 32 + 4 * h) * 2;
    bf16x8 vf[2][2];
#pragma unroll
    for (int g = 0; g < 2; ++g)
#pragma unroll
        for (int s = 0; s < 2; ++s) {
            const s16x4 lo = *(LAS const s16x4*)(vp + g * 32 * LDS_VROW + 32 * s);
            const s16x4 hi = *(LAS const s16x4*)(vp + g * 32 * LDS_VROW + 32 * s + 16);
            vf[g][s] = __builtin_shufflevector(lo, hi, 0, 1, 2, 3, 4, 5, 6, 7);
        }
    f32x16 sc = zero16();
#pragma unroll
    for (int i = 0; i < 4; ++i) sc = MFMA32(kf[i], qf[i], sc);
    float sv[16]; float tmax = -1e30f;
#pragma unroll
    for (int i = 0; i < 16; ++i) {
        bool ok = lane_ok;
        if (KEYMASK) { const int kpos = kb + (i & 3) + 8 * (i >> 2) + 4 * h; ok = ok && mask(kpos); }
        sv[i] = ok ? sc[i] : -1e30f;
        tmax = fmaxf(tmax, sv[i]);
    }
    tmax = xmax32(tmax);
    const float mn = fmaxf(st.m, tmax * SCL2);
    const float alpha = __builtin_amdgcn_exp2f(st.m - mn);
    float p[16]; float psum = 0.f;
#pragma unroll
    for (int i = 0; i < 16; ++i) { p[i] = __builtin_amdgcn_exp2f(__builtin_fmaf(sv[i], SCL2, -mn)); psum += p[i]; }
    const bool resc = __builtin_amdgcn_ballot_w64(mn > st.m) != 0ull;
    st.l = st.l * alpha + psum; st.m = mn;
    if (resc) { st.o0 = st.o0 * alpha; st.o1 = st.o1 * alpha; }
    const bf16x8 pf0 = __builtin_bit_cast(bf16x8, ((u32x4){pk2(p[0], p[1]), pk2(p[2], p[3]), pk2(p[4], p[5]), pk2(p[6], p[7])}));
    const bf16x8 pf1 = __builtin_bit_cast(bf16x8, ((u32x4){pk2(p[8], p[9]), pk2(p[10], p[11]), pk2(p[12], p[13]), pk2(p[14], p[15])}));
    st.o0 = MFMA32(vf[0][0], pf0, st.o0); st.o0 = MFMA32(vf[0][1], pf1, st.o0);
    st.o1 = MFMA32(vf[1][0], pf0, st.o1); st.o1 = MFMA32(vf[1][1], pf1, st.o1);
}
struct NextDesc { const bf16_t* K; const bf16_t* Vt; int vts, kb0, n, kstride, koff; bool valid; };
DI NextDesc no_next() { NextDesc d; d.K = nullptr; d.Vt = nullptr; d.vts = 0; d.kb0 = 0; d.n = 0; d.kstride = 1; d.koff = 0; d.valid = false; return d; }
template <int AUX = 0>
DI void stage_dma_desc(LAS unsigned char* buf, const NextDesc& d, int wid, int lane) { stage_dma<AUX>(buf, d.K, d.Vt, d.vts, d.kb0, d.n, wid, lane, d.kstride, d.koff); }
template <int AUX = 0, class MaskF, class WantF, class LaneF, class NeedF>
DI void attn_sweep(AState& st, const bf16x8 (&qf)[4], LAS unsigned char* lds, const bf16_t* Kg, const bf16_t* Vtg, int vts, int KB0, int KB1, int lo, int hi, int wid, int lane, int r, int h,
                   const MaskF& mask, const WantF& want, const LaneF& lanef, const NeedF& needkey, int kstride, int koff, int& bufsel, bool& pre, const NextDesc& nd) {
    if (KB0 >= KB1) return;
    if (!pre) stage_dma<AUX>(lds + bufsel * LDS_ABUF, Kg, Vtg, vts, KB0, (KB1 - KB0) < 256 ? (KB1 - KB0) : 256, wid, lane, kstride, koff);
    pre = false;
#pragma unroll 1
    for (int s0 = KB0; s0 < KB1; s0 += 256, bufsel ^= 1) {
        asm volatile("s_waitcnt vmcnt(0)" ::: "memory");
        __syncthreads();
        const int nx = s0 + 256;
        if (nx < KB1) stage_dma<AUX>(lds + (bufsel ^ 1) * LDS_ABUF, Kg, Vtg, vts, nx, (KB1 - nx) < 256 ? (KB1 - nx) : 256, wid, lane, kstride, koff);
        else if (nd.valid) { stage_dma_desc<AUX>(lds + (bufsel ^ 1) * LDS_ABUF, nd, wid, lane); pre = true; }
        LAS const unsigned char* cur = lds + bufsel * LDS_ABUF;
        const int n = (KB1 - s0) < 256 ? (KB1 - s0) : 256, nt = n >> 5;
#pragma unroll 1
        for (int ti = 0; ti < nt; ++ti) {
            const int kb = s0 + 32 * ti;
            if (kb >= lo && kb <= hi && want(kb)) {
                if (needkey(kb)) attn_tile<true>(st, qf, cur, ti, kb, r, h, lanef(kb), mask);
                else attn_tile<false>(st, qf, cur, ti, kb, r, h, lanef(kb), mask);
            }
        }
    }
}
DI void store_o(bf16_t* dst, const f32x16& o0, const f32x16& o1, int h) {
#pragma unroll
    for (int g = 0; g < 2; ++g) {
        const f32x16& o = g ? o1 : o0;
#pragma unroll
        for (int a = 0; a < 2; ++a) {
            const unsigned ax = pk2(o[4 * a], o[4 * a + 1]), ay = pk2(o[4 * a + 2], o[4 * a + 3]);
            const unsigned bx = pk2(o[4 * a + 8], o[4 * a + 9]), by = pk2(o[4 * a + 10], o[4 * a + 11]);
            const auto rx = __builtin_amdgcn_permlane32_swap(ax, bx, false, false);
            const auto ry = __builtin_amdgcn_permlane32_swap(ay, by, false, false);
            *(u32x4*)(dst + 32 * g + 8 * (a + 2 * h)) = (u32x4){rx[0], ry[0], rx[1], ry[1]};
        }
    }
}
DI unsigned wave_or(unsigned v) {
#pragma unroll
    for (int o = 1; o < 64; o <<= 1) v |= (unsigned)__shfl_xor((int)v, o);
    return (unsigned)__builtin_amdgcn_readfirstlane((int)v);
}
struct WantAll { DI bool operator()(int) const { return true; } };
struct LaneAll { DI bool operator()(int) const { return true; } };
struct NeedAlways { DI bool operator()(int) const { return true; } };

DI NextDesc first_stage_swa(unsigned char* ws, int bi, int nitems) {
    NextDesc d = no_next();
    if (bi < nitems) {
        const int bh = bi & 63, tb = bi >> 6, T0 = tb * 256, b = bh >> 3, hk = (bh & 7) >> 2;
        d.K = (const bf16_t*)(ws + OFF_KA) + (size_t)(b * 2 + hk) * T * 64; d.Vt = (const bf16_t*)(ws + OFF_VTA) + (size_t)(b * 2 + hk) * 64 * T;
        d.vts = T; d.kb0 = T0 >= 128 ? T0 - 128 : 0; d.n = 256; d.valid = true;
    }
    return d;
}
DI void item_swa(const Params& p, int bi, int bi_next, int wid, int lane, int r, int h, LAS unsigned char* lds, int& bufsel, bool& pre) {
    asm volatile("" : "+v"(lane), "+v"(r), "+v"(h));
    unsigned char* ws = launder(p.ws);
    const int bh = bi & 63, tb = bi >> 6;
    const int T0 = tb * 256, t0 = T0 + wid * 32, b = bh >> 3, qh = bh & 7, hk = qh >> 2;
    const int tq = t0 + r;
    bf16x8 qf[4];
    load_q(qf, (const bf16_t*)(ws + OFF_QA) + ((size_t)(b * 8 + qh) * T + tq) * 64, h);
    const bf16_t* K = (const bf16_t*)(ws + OFF_KA) + (size_t)(b * 2 + hk) * T * 64;
    const bf16_t* Vt = (const bf16_t*)(ws + OFF_VTA) + (size_t)(b * 2 + hk) * 64 * T;
    AState st; astate_init(st);
    const int KB0 = T0 >= 128 ? T0 - 128 : 0;
    int lo = t0 - 127; lo = lo < 0 ? 0 : (lo & ~31);
    auto mask = [=](int kpos) { return kpos <= tq && tq - kpos <= 127; };
    auto need = [=](int kb) { return !(kb + 31 <= t0 && kb >= t0 + 31 - 127); };
    attn_sweep(st, qf, lds, K, Vt, T, KB0, T0 + 256, lo, t0, wid, lane, r, h, mask, WantAll(), LaneAll(), need, 1, 0, bufsel, pre, first_stage_swa(ws, bi_next, 1024));
    const float lt = st.l + __shfl_xor(st.l, 32);
    const float sk = ((const float*)(ws + OFF_SINK))[qh];
    const float mnat = st.m * LN2;
    const float mf = fmaxf(mnat, sk);
    const float e1 = __expf(mnat - mf);
    float den = lt * e1 + __expf(sk - mf);
    den = den > 0.f ? den : 1.f;
    const float f = e1 / den;
    store_o((bf16_t*)(ws + OFF_MIX) + (size_t)(b * T + tq) * 1024 + qh * 64, st.o0 * f, st.o1 * f, h);
}

DI void nsa_geo(int bi, int& b, int& hk, int& T0) {
    const int bh = bi & 15, tbr = bi >> 4, tk = tbr >> 4, tx = tbr & 15, tb = (tk & 1) ? (16 * tk + 15 - tx) : (16 * tk + tx);
    b = bh >> 1; hk = bh & 1; T0 = tb * 64;
}
DI NextDesc first_stage_nsa(unsigned char* ws, int bi, int nitems) {
    NextDesc d = no_next();
    if (bi < nitems) {
        int b, hk, T0; nsa_geo(bi, b, hk, T0);
        d.K = (const bf16_t*)(ws + OFF_KC) + (size_t)(b * 2 + hk) * 256 * 64; d.Vt = (const bf16_t*)(ws + OFF_VTC) + (size_t)(b * 2 + hk) * 64 * 256;
        d.vts = 256; d.kb0 = 0; d.n = ((((T0 + 63 - 31) >> 4) >> 5) + 1) * 32; d.valid = true;
    }
    return d;
}
DI void item_nsa(const Params& p, int bi, int bi_next, int wid, int lane, int r, int h, LAS unsigned char* lds, int& bufsel, bool& pre) {
    asm volatile("" : "+v"(lane), "+v"(r), "+v"(h));
    unsigned char* ws = launder(p.ws);
    int b, hk, T0; nsa_geo(bi, b, hk, T0);
    const int t0 = T0 + wid * 8;
    const int tq = t0 + (r >> 2), qh = hk * 4 + (r & 3);
    const float* gate = (const float*)(ws + OFF_GATE) + (size_t)(b * T + tq) * 24 + qh * 3;
    const float g0 = gate[0], g1 = gate[1], g2 = gate[2];
    f32x16 f0, f1;
    unsigned sel_lo = 0u, sel_hi = 0u;
    bf16x8 qf[4];
    {
        load_q(qf, (const bf16_t*)(ws + OFF_QBG) + ((size_t)(b * 8 + qh) * T + tq) * 64, h);
        const bf16_t* K = (const bf16_t*)(ws + OFF_KC) + (size_t)(b * 2 + hk) * 256 * 64;
        const bf16_t* Vt = (const bf16_t*)(ws + OFF_VTC) + (size_t)(b * 2 + hk) * 64 * 256;
        AState st; astate_init(st);
        const int nmaxb = (T0 + 63 - 31) >> 4, nmax = (t0 + 7 - 31) >> 4;
        const int KB1 = ((nmaxb >> 5) + 1) * 32;
        auto mask = [=](int n) { return 16 * n + 31 <= tq; };
        if (!pre) stage_dma(lds + bufsel * LDS_ABUF, K, Vt, 256, 0, KB1, wid, lane);
        pre = false;
        asm volatile("s_waitcnt vmcnt(0)" ::: "memory");
        __syncthreads();
        {
            NextDesc nd = no_next();
            nd.K = (const bf16_t*)(ws + OFF_KS) + (size_t)(b * 2 + hk) * T * 64; nd.Vt = (const bf16_t*)(ws + OFF_VTS) + (size_t)(b * 2 + hk) * 64 * T;
            nd.vts = T; nd.kb0 = 0; nd.n = (T0 + 64) < 256 ? (T0 + 64) : 256; nd.valid = true;
            stage_dma_desc(lds + (bufsel ^ 1) * LDS_ABUF, nd, wid, lane); pre = true;
        }
        LAS unsigned char* cbuf = lds + bufsel * LDS_ABUF;
        bufsel ^= 1;
#pragma unroll 1
        for (int ti = 0; ti < 8; ++ti) { if (32 * ti <= nmax) attn_tile<true>(st, qf, cbuf, ti, 32 * ti, r, h, true, mask); }
        const float lt = st.l + __shfl_xor(st.l, 32);
        const float inv = lt > 0.f ? 1.0f / lt : 1.0f;
        f0 = st.o0 * (inv * g0); f1 = st.o1 * (inv * g0);
        float imp[32];
        const float mfin = st.m;
        float carry = 0.f;
#pragma unroll
        for (int ti = 0; ti < 8; ++ti) {
            f32x16 sc = zero16();
            if (32 * ti <= nmax) sc = qk_tile_lds(qf, cbuf, ti, r, h);
#pragma unroll
            for (int a = 0; a < 4; ++a) {
                float pv[4];
#pragma unroll
                for (int jj = 0; jj < 4; ++jj) {
                    const int n = 32 * ti + 8 * a + 4 * h + jj;
                    pv[jj] = (32 * ti <= nmax && 16 * n + 31 <= tq) ? __builtin_amdgcn_exp2f(sc[4 * a + jj] * SCL2 - mfin) * inv : 0.f;
                }
                float mainv = pv[0] + pv[1] + pv[2] + 0.5f * pv[3];
                const float spill = 0.5f * pv[3];
                const float other = xother32(spill, h);
                mainv += (h == 1) ? other : carry;
                carry = other;
                mainv = quad_sum(mainv);
                imp[ti * 4 + a] = mainv;
            }
        }
        const int cb = tq >> 6;
        { const int f1 = cb, f2 = cb > 0 ? cb - 1 : 0;
          sel_lo |= 1u; if (f1 < 32) sel_lo |= 1u << f1; else sel_hi |= 1u << (f1 - 32); if (f2 < 32) sel_lo |= 1u << f2; else sel_hi |= 1u << (f2 - 32); }
#pragma unroll
        for (int i = 0; i < 32; ++i) {
            const int j = 8 * (i >> 2) + 2 * (i & 3) + h;
            imp[i] = (j < cb - 1 && j != 0) ? imp[i] : -1e30f;
        }
        const int nforced = cb >= 2 ? 3 : cb + 1;
        if (cb > 7) {
#pragma unroll 1
            for (int it = 0; it < 8 - nforced; ++it) {
                float bv = -3e38f; int bj = 64;
#pragma unroll
                for (int i = 0; i < 32; ++i) { if (imp[i] > bv) { bv = imp[i]; bj = 8 * (i >> 2) + 2 * (i & 3) + h; } }
                const float ov = xother32(bv, h); const int oj = xother32i(bj, h);
                if (ov > bv || (ov == bv && oj < bj)) { bv = ov; bj = oj; }
                if (bv > -5e29f) { if (bj < 32) sel_lo |= 1u << bj; else sel_hi |= 1u << (bj - 32); }
#pragma unroll
                for (int i = 0; i < 32; ++i) { if (8 * (i >> 2) + 2 * (i & 3) + h == bj) imp[i] = -3e38f; }
            }
        } else {
            sel_lo |= (2u << cb) - 1u;
        }
    }
    load_q(qf, (const bf16_t*)(ws + OFF_QBR) + ((size_t)(b * 8 + qh) * T + tq) * 64, h);
    {
        const bf16_t* K = (const bf16_t*)(ws + OFF_KS) + (size_t)(b * 2 + hk) * T * 64;
        const bf16_t* Vt = (const bf16_t*)(ws + OFF_VTS) + (size_t)(b * 2 + hk) * 64 * T;
        AState st; astate_init(st);
        const unsigned ulo = wave_or(sel_lo), uhi = wave_or(sel_hi);
        auto mask = [=](int kpos) { return kpos <= tq; };
        auto lanef = [=](int kb) { const int j = kb >> 6; return (j < 32 ? (sel_lo >> j) & 1u : (sel_hi >> (j - 32)) & 1u) != 0u; };
        auto need = [=](int kb) { return kb + 31 > t0; };
        auto want = [=](int kb) { const int j = kb >> 6; return (j < 32 ? (ulo >> j) & 1u : (uhi >> (j - 32)) & 1u) != 0u; };
        NextDesc nd = no_next();
        { const int kw0 = T0 >= 512 ? T0 - 512 : 0;
          nd.K = (const bf16_t*)(ws + OFF_KW) + (size_t)(b * 2 + hk) * T * 64; nd.Vt = (const bf16_t*)(ws + OFF_VTW) + (size_t)(b * 2 + hk) * 64 * T;
          nd.vts = T; nd.kb0 = kw0; nd.n = (T0 + 64 - kw0) < 256 ? (T0 + 64 - kw0) : 256; nd.valid = true; }
        attn_sweep(st, qf, lds, K, Vt, T, 0, T0 + 64, 0, (t0 + 7) & ~31, wid, lane, r, h, mask, want, lanef, need, 1, 0, bufsel, pre, nd);
        const float lt = st.l + __shfl_xor(st.l, 32);
        const float inv = (lt > 0.f ? 1.0f / lt : 1.0f) * g1;
        f0 = f0 + st.o0 * inv; f1 = f1 + st.o1 * inv;
    }
    {
        const bf16_t* K = (const bf16_t*)(ws + OFF_KW) + (size_t)(b * 2 + hk) * T * 64;
        const bf16_t* Vt = (const bf16_t*)(ws + OFF_VTW) + (size_t)(b * 2 + hk) * 64 * T;
        AState st; astate_init(st);
        const int KB0 = T0 >= 512 ? T0 - 512 : 0;
        int lo = t0 - 511; lo = lo < 0 ? 0 : (lo & ~31);
        auto mask = [=](int kpos) { return kpos <= tq && tq - kpos <= 511; };
        auto need = [=](int kb) { return !(kb + 31 <= t0 && kb >= t0 + 7 - 511); };
        attn_sweep(st, qf, lds, K, Vt, T, KB0, T0 + 64, lo, (t0 + 7) & ~31, wid, lane, r, h, mask, WantAll(), LaneAll(), need, 1, 0, bufsel, pre, first_stage_nsa(ws, bi_next, 1024));
        const float lt = st.l + __shfl_xor(st.l, 32);
        const float inv = (lt > 0.f ? 1.0f / lt : 1.0f) * g2;
        f0 = f0 + st.o0 * inv; f1 = f1 + st.o1 * inv;
    }
    store_o((bf16_t*)(ws + OFF_MIX) + (size_t)(b * T + tq) * 1024 + 512 + qh * 64, f0, f1, h);
}

DI void dil_geo(int bi, int& gi, int& b, int& slot, int& sh, int& rho, int& L0) {
    gi = bi >> 9; const int rem = bi & 511, bh = rem & 31, cl = rem >> 5;
    sh = gi == 0 ? 0 : (gi == 1 ? 2 : 4);
    rho = cl & ((1 << sh) - 1); L0 = (cl >> sh) * 256; b = bh >> 2; slot = bh & 3;
}
DI NextDesc first_stage_dil(unsigned char* ws, int bi, int nitems) {
    NextDesc d = no_next();
    if (bi < nitems) {
        int gi, b, slot, sh, rho, L0; dil_geo(bi, gi, b, slot, sh, rho, L0);
        const int hd = gi * 4 + slot, L = T >> sh;
        d.K = (const bf16_t*)(ws + OFF_CK) + (size_t)(b * 12 + hd) * T * 64; d.Vt = (const bf16_t*)(ws + OFF_VTCD) + (size_t)(b * 12 + hd) * 64 * T + rho * L;
        d.vts = T; d.kb0 = L0 >= 128 ? L0 - 128 : 0; d.n = 256; d.kstride = 1 << sh; d.koff = rho; d.valid = true;
    }
    return d;
}
DI void item_dilated(const Params& p, int bi, int bi_next, int wid, int lane, int r, int h, LAS unsigned char* lds, int& bufsel, bool& pre) {
    asm volatile("" : "+v"(lane), "+v"(r), "+v"(h));
    unsigned char* ws = launder(p.ws);
    int gi, b, slot, sh, rho, L0; dil_geo(bi, gi, b, slot, sh, rho, L0);
    const int rr = 1 << sh, L = T >> sh;
    const int l0 = L0 + wid * 32, hd = gi * 4 + slot;
    const int lq = l0 + r, tq = (lq << sh) + rho;
    bf16x8 qf[4];
    load_q(qf, (const bf16_t*)(ws + OFF_CQ) + ((size_t)(b * 12 + hd) * T + tq) * 64, h);
    const bf16_t* K = (const bf16_t*)(ws + OFF_CK) + (size_t)(b * 12 + hd) * T * 64;
    const bf16_t* Vt = (const bf16_t*)(ws + OFF_VTCD) + (size_t)(b * 12 + hd) * 64 * T + rho * L;
    AState st; astate_init(st);
    const int KB0 = L0 >= 128 ? L0 - 128 : 0;
    int lo = l0 - 128; lo = lo < 0 ? 0 : (lo & ~31);
    auto mask = [=](int kpos) { return kpos <= lq && lq - kpos <= 128; };
    auto need = [=](int kb) { return !(kb + 31 <= l0 && kb >= l0 + 31 - 128); };
    attn_sweep<2>(st, qf, lds, K, Vt, T, KB0, L0 + 256, lo, l0, wid, lane, r, h, mask, WantAll(), LaneAll(), need, rr, rho, bufsel, pre, first_stage_dil(ws, bi_next, 1536));
    float lt = st.l + __shfl_xor(st.l, 32);
    lt = lt > 0.f ? lt : 1.f;
    const float inv = 1.0f / lt;
    store_o((bf16_t*)(ws + OFF_OG) + ((size_t)gi * NTOK + (size_t)b * T + tq) * 256 + slot * 64, st.o0 * inv, st.o1 * inv, h);
    if (h == 0) ((float*)(ws + OFF_LSEG))[((size_t)gi * NTOK + (size_t)b * T + tq) * 4 + slot] = st.m * LN2 + __logf(lt);
}
DI void phase_dilmerge(const Params& p) {
    unsigned char* ws = launder(p.ws);
    int tid = threadIdx.x; asm volatile("" : "+v"(tid));
    const bf16_t* og = (const bf16_t*)(ws + OFF_OG);
    const float* lse = (const float*)(ws + OFF_LSEG);
    bf16_t* mix = (bf16_t*)(ws + OFF_MIX2);
    for (int i = blockIdx.x * 512 + tid; i < NTOK * 32; i += gridDim.x * 512) {
        const int tok = i >> 5, c = i & 31, slot = c >> 3;
        const float a0 = lse[(size_t)tok * 4 + slot], a1 = lse[((size_t)NTOK + tok) * 4 + slot], a2 = lse[((size_t)2 * NTOK + tok) * 4 + slot];
        const float mx = fmaxf(a0, fmaxf(a1, a2));
        float w0 = __expf(a0 - mx), w1 = __expf(a1 - mx), w2 = __expf(a2 - mx);
        const float iw = 1.0f / (w0 + w1 + w2); w0 *= iw; w1 *= iw; w2 *= iw;
        const u32x4 x0 = __builtin_nontemporal_load((const u32x4*)(og + (size_t)tok * 256 + c * 8));
        const u32x4 x1 = __builtin_nontemporal_load((const u32x4*)(og + ((size_t)NTOK + tok) * 256 + c * 8));
        const u32x4 x2 = __builtin_nontemporal_load((const u32x4*)(og + ((size_t)2 * NTOK + tok) * 256 + c * 8));
        u32x4 o;
#pragma unroll
        for (int e = 0; e < 4; ++e) {
            const float lo = w0 * __uint_as_float(x0[e] << 16) + w1 * __uint_as_float(x1[e] << 16) + w2 * __uint_as_float(x2[e] << 16);
            const float hi = w0 * __uint_as_float(x0[e] & 0xffff0000u) + w1 * __uint_as_float(x1[e] & 0xffff0000u) + w2 * __uint_as_float(x2[e] & 0xffff0000u);
            o[e] = pk2(lo, hi);
        }
        *(u32x4*)(mix + (size_t)tok * 512 + c * 8) = o;
    }
}

DI void moba_geo(int bi, int& b, int& hd, int& cb) { const int bh = bi & 31, cbr = bi >> 5; cb = cbr < 8 ? cbr : 23 - cbr; b = bh >> 2; hd = bh & 3; }
DI NextDesc first_stage_moba(unsigned char* ws, int bi, int nitems) {
    NextDesc d = no_next();
    if (bi < nitems) {
        int b, hd, cb; moba_geo(bi, b, hd, cb);
        d.K = (const bf16_t*)(ws + OFF_DK) + (size_t)(b * 4 + hd) * T * 64; d.Vt = (const bf16_t*)(ws + OFF_VTD) + (size_t)(b * 4 + hd) * 64 * T;
        d.vts = T; d.kb0 = 0; d.n = 256; d.valid = true;
    }
    return d;
}
DI void item_moba(const Params& p, int bi, int bi_next, int wid, int lane, int r, int h, LAS unsigned char* lds, int& bufsel, bool& pre) {
    asm volatile("" : "+v"(lane), "+v"(r), "+v"(h));
    unsigned char* ws = launder(p.ws);
    int b, hd, cb; moba_geo(bi, b, hd, cb);
    const int T0 = cb * 256, t0 = T0 + wid * 32;
    const int tq = t0 + r;
    bf16x8 qf[4];
    load_q(qf, (const bf16_t*)(ws + OFF_DQ) + ((size_t)(b * 4 + hd) * T + tq) * 64, h);
    unsigned sel = 0u;
    if (cb > 0) {
        const bf16_t* kp = (const bf16_t*)(ws + OFF_KMEAN) + ((size_t)(b * 4 + hd) * 32 + r) * 64 + 8 * h;
        bf16x8 kf[4];
#pragma unroll
        for (int i = 0; i < 4; ++i) kf[i] = *(const bf16x8*)(kp + 16 * i);
        f32x16 gs = zero16();
#pragma unroll
        for (int i = 0; i < 4; ++i) gs = MFMA32(kf[i], qf[i], gs);
        float sc[8];
#pragma unroll
        for (int i = 0; i < 8; ++i) { const int n = (i & 3) + 8 * (i >> 2) + 4 * h; sc[i] = n < cb ? gs[i] : -1e30f; }
        for (int it = 0; it < 3; ++it) {
            float bv = -3e38f; int bj = 64;
#pragma unroll
            for (int i = 0; i < 8; ++i) { if (sc[i] > bv) { bv = sc[i]; bj = (i & 3) + 8 * (i >> 2) + 4 * h; } }
            const float ov = xother32(bv, h); const int oj = xother32i(bj, h);
            if (ov > bv || (ov == bv && oj < bj)) { bv = ov; bj = oj; }
            if (bv > -5e29f) sel |= 1u << bj;
#pragma unroll
            for (int i = 0; i < 8; ++i) { if ((i & 3) + 8 * (i >> 2) + 4 * h == bj) sc[i] = -3e38f; }
        }
    }
    const bf16_t* K = (const bf16_t*)(ws + OFF_DK) + (size_t)(b * 4 + hd) * T * 64;
    const bf16_t* Vt = (const bf16_t*)(ws + OFF_VTD) + (size_t)(b * 4 + hd) * 64 * T;
    AState st; astate_init(st);
    const unsigned usel = wave_or(sel);
    {
        auto mask = [=](int) { return true; };
        auto lanef = [=](int kb) { return ((sel >> (kb >> 8)) & 1u) != 0u; };
        auto want = [=](int kb) { return ((usel >> (kb >> 8)) & 1u) != 0u; };
        auto need = [=](int) { return false; };
        NextDesc nd = no_next(); nd.K = K; nd.Vt = Vt; nd.vts = T; nd.kb0 = T0; nd.n = 256; nd.valid = true;
        attn_sweep(st, qf, lds, K, Vt, T, 0, T0, 0, T0, wid, lane, r, h, mask, want, lanef, need, 1, 0, bufsel, pre, nd);
    }
    {
        auto mask = [=](int kpos) { return kpos <= tq; };
        auto need = [=](int kb) { return kb + 31 > t0; };
        attn_sweep(st, qf, lds, K, Vt, T, T0, T0 + 256, T0, t0, wid, lane, r, h, mask, WantAll(), LaneAll(), need, 1, 0, bufsel, pre, first_stage_moba(ws, bi_next, 512));
    }
    const float lt = st.l + __shfl_xor(st.l, 32);
    const float inv = lt > 0.f ? 1.0f / lt : 1.0f;
    store_o((bf16_t*)(ws + OFF_MIX2) + (size_t)(b * T + tq) * 512 + 256 + hd * 64, st.o0 * inv, st.o1 * inv, h);
}

enum { MAP_ID = 0, MAP_WI = 1, MAP_WIN = 2, MAP_PERM = 3 };
DI int map_src(int kind, int pidx, int nvalid) {
    if (kind == MAP_ID) return pidx < nvalid ? pidx : -1;
    if (kind == MAP_PERM) { const int rho = pidx & 31, n = rho >> 4, i = rho & 15; return (pidx & ~31) + 8 * (i >> 2) + 4 * n + (i & 3); }
    const int pn = pidx >> 8, q = pidx & 255, bj = q >> 7, wc = (q >> 5) & 3, n = (q >> 4) & 1, fq = (q >> 2) & 3, j = q & 3;
    if (kind == MAP_WI) return bj * DFF + 128 * pn + 32 * wc + 8 * fq + 4 * n + j;
    const int L = 256 * pn + 64 * wc + 32 * bj + 8 * fq + 4 * n + j;
    return L < nvalid ? L : -1;
}
DI void prep_tile(const float* W, int ldw, int Kdim, bf16_t* Wt, int kind, int nvalid, const float* g, int tile, float* tl) {
    const int tk = Kdim >> 7, pt = tile / tk, kt = tile - pt * tk, p0 = pt * 64, k0 = kt * 128, tid = threadIdx.x;
#pragma unroll
    for (int i = 0; i < 4; ++i) {
        const int e = tid + i * 512, kk = e >> 4, pq = (e & 15) * 4;
        const int src = map_src(kind, p0 + pq, nvalid);
        f32x4 v = {0.f, 0.f, 0.f, 0.f};
        if (src >= 0) { v = __builtin_nontemporal_load((const f32x4*)(W + (size_t)(k0 + kk) * ldw + src)); if (g) v = v * g[k0 + kk]; }
        float* d = tl + kk * 65 + pq;
        d[0] = v[0]; d[1] = v[1]; d[2] = v[2]; d[3] = v[3];
    }
    __syncthreads();
    {
        const int pp = tid >> 3, kc = (tid & 7) * 16;
        float v[16];
#pragma unroll
        for (int i = 0; i < 16; ++i) v[i] = tl[(kc + i) * 65 + pp];
        bf16_t* d = Wt + (size_t)(p0 + pp) * Kdim + k0 + kc;
        *(u32x4*)d = (u32x4){pk2(v[0], v[1]), pk2(v[2], v[3]), pk2(v[4], v[5]), pk2(v[6], v[7])};
        *(u32x4*)(d + 8) = (u32x4){pk2(v[8], v[9]), pk2(v[10], v[11]), pk2(v[12], v[13]), pk2(v[14], v[15])};
    }
    __syncthreads();
}
DI void prep_weights(const Params& p, float* tl, unsigned jobmask, int blk, int nblk);
DI void phase_prep(const Params& p, float* tl) {
    unsigned char* ws = p.ws;
    const int nblk = gridDim.x, blk = blockIdx.x, tid = threadIdx.x, lane = tid & 63, wid = tid >> 6;
    const int gw = blk * 8 + wid, nw = nblk * 8;
    {
        const float* x = p.in[0];
        bf16_t* hb = (bf16_t*)(ws + OFF_HB);
        float* ss = (float*)(ws + OFF_SS);
        for (int row = gw; row < NTOK; row += 2 * nw) {
            const int rows[2] = {row, row + nw < NTOK ? row + nw : row};
            f32x4 v[2][4];
#pragma unroll
            for (int k = 0; k < 2; ++k)
#pragma unroll
                for (int i = 0; i < 4; ++i) v[k][i] = __builtin_nontemporal_load((const f32x4*)(x + (size_t)rows[k] * DM + i * 256 + lane * 4));
#pragma unroll
            for (int k = 0; k < 2; ++k) {
                float sq = 0.f;
#pragma unroll
                for (int i = 0; i < 4; ++i) {
                    *(u32x2*)(hb + (size_t)rows[k] * DM + i * 256 + lane * 4) = (u32x2){pk2(v[k][i][0], v[k][i][1]), pk2(v[k][i][2], v[k][i][3])};
                    sq += v[k][i][0] * v[k][i][0] + v[k][i][1] * v[k][i][1] + v[k][i][2] * v[k][i][2] + v[k][i][3] * v[k][i][3];
                }
#pragma unroll
                for (int o = 1; o < 64; o <<= 1) sq += __shfl_xor(sq, o);
                if (lane < 16) ss[(size_t)rows[k] * 16 + lane] = lane == 0 ? sq : 0.f;
            }
        }
    }
    if (blk == 0) { if (tid < 8) ((float*)(ws + OFF_SINK))[tid] = p.in[8][tid]; for (int i = tid; i < 1024; i += 512) ((float*)(ws + OFF_FNG))[i] = p.in[14][i]; }
    {
        f32x2* rope = (f32x2*)(ws + OFF_ROPE);
        for (int i = blk * 512 + tid; i < T * 32; i += nblk * 512) {
            const int t = i >> 5, f = i & 31;
            const float inv = 1.0f / powf(10000.0f, (float)(2 * f) / 64.0f);
            const float ang = (float)t * inv;
            const double a = (double)ang;
            const double k = rint(a * 0.15915494309189535);
            const float rr = (float)(a - k * 6.283185307179586);
            rope[i] = (f32x2){__cosf(rr), __sinf(rr)};
        }
    }
    {
        float* cb = (float*)(ws + OFF_CBIAS);
        for (int o = gw; o < 512; o += nw) {
            const int kv = o >> 8, c = o & 255;
            const float* pe = p.in[9] + (size_t)kv * 2048;
            const float* w1 = p.in[10] + (size_t)kv * 2048 * 256;
            float s = 0.f;
            for (int i = lane; i < 2048; i += 64) s += pe[i] * w1[(size_t)i * 256 + c];
#pragma unroll
            for (int of = 1; of < 64; of <<= 1) s += __shfl_xor(s, of);
            if (lane == 0) cb[o] = s;
        }
    }
    prep_weights(p, tl, 0xF111u, blockIdx.x, gridDim.x);
}
DI void prep_weights(const Params& p, float* tl, unsigned jobmask, int blk, int nblk) {
    unsigned char* ws = launder(p.ws);
    int base = 0;
    for (int job = 0; job < 16; ++job) {
        if (!((jobmask >> job) & 1u)) continue;
        const float* W; int ldw, Kdim, P, kind, nvalid; bf16_t* Wt; const float* g = nullptr;
        if (job < 4) { const int l = job >> 1, wh = job & 1; W = p.in[4] + (size_t)job * DM * 2 * DFF; ldw = 2 * DFF; Kdim = DM; P = 2 * DFF; kind = MAP_WI; nvalid = 2 * DFF;
            Wt = (bf16_t*)(ws + OFF_WI) + (size_t)job * 5632 * 1024; g = (wh == 0 ? p.in[1] : p.in[3]) + l * DM; }
        else if (job < 8) { const int q = job - 4; W = p.in[5] + (size_t)q * DFF * DM; ldw = DM; Kdim = DFF; P = DM; kind = MAP_PERM; nvalid = DM; Wt = (bf16_t*)(ws + OFF_WO) + (size_t)q * 1024 * 2816; }
        else if (job == 8) { W = p.in[6]; ldw = 2072; Kdim = DM; P = 2304; kind = MAP_WIN; nvalid = 2072; Wt = (bf16_t*)(ws + OFF_EWIN); g = p.in[2]; }
        else if (job == 9) { W = p.in[7]; ldw = DM; Kdim = 1024; P = DM; kind = MAP_PERM; nvalid = DM; Wt = (bf16_t*)(ws + OFF_EWOUT); }
        else if (job == 10) { W = p.in[12]; ldw = 3072; Kdim = DM; P = 3072; kind = MAP_WIN; nvalid = 3072; Wt = (bf16_t*)(ws + OFF_OWIN); g = p.in[2] + DM; }
        else if (job == 11) { W = p.in[13]; ldw = DM; Kdim = 512; P = DM; kind = MAP_PERM; nvalid = DM; Wt = (bf16_t*)(ws + OFF_OWOUT); }
        else if (job < 14) { const int kv = job - 12; W = p.in[10] + (size_t)kv * 2048 * 256; ldw = 256; Kdim = 2048; P = 256; kind = MAP_ID; nvalid = 256; Wt = (bf16_t*)(ws + OFF_CW1) + (size_t)kv * 256 * 2048; }
        else { const int kv = job - 14; W = p.in[11] + (size_t)kv * 256 * 64; ldw = 64; Kdim = 256; P = 256; kind = MAP_ID; nvalid = 64; Wt = (bf16_t*)(ws + OFF_CW2) + (size_t)kv * 256 * 256; }
        const int ntile = (P >> 6) * (Kdim >> 7);
        int first = (blk - base % nblk + nblk) % nblk;
        for (int tile = first; tile < ntile; tile += nblk) prep_tile(W, ldw, Kdim, Wt, kind, nvalid, g, tile, tl);
        base += ntile;
    }
}

DI void phase_kmean(const Params& p) {
    unsigned char* ws = launder(p.ws);
    int tid = threadIdx.x; asm volatile("" : "+v"(tid));
    const int lane = tid & 63, gw = blockIdx.x * 8 + (tid >> 6), nw = gridDim.x * 8;
    bf16_t* km = (bf16_t*)(ws + OFF_KMEAN);
    const int sub = lane >> 3, part = lane & 7;
    for (int it = gw; it < 1024; it += nw) {
        const int bh = it >> 5, n = it & 31;
        float acc[8] = {0.f, 0.f, 0.f, 0.f, 0.f, 0.f, 0.f, 0.f};
        if (n < 16) {
            const bf16_t* kp = (const bf16_t*)(ws + OFF_DK) + ((size_t)bh * T + n * 256 + sub) * 64 + part * 8;
#pragma unroll 8
            for (int i = 0; i < 32; ++i) {
                const u32x4 q = *(const u32x4*)(kp + (size_t)i * 8 * 64);
#pragma unroll
                for (int e = 0; e < 4; ++e) { acc[2 * e] += __uint_as_float(q[e] << 16); acc[2 * e + 1] += __uint_as_float(q[e] & 0xffff0000u); }
            }
#pragma unroll
            for (int e = 0; e < 8; ++e) { float t = acc[e]; t += __shfl_xor(t, 8); t += __shfl_xor(t, 16); t += __shfl_xor(t, 32); acc[e] = t * (1.0f / 256.0f); }
        }
        if (sub == 0) *(u32x4*)(km + (size_t)it * 64 + part * 8) = (u32x4){pk2(acc[0], acc[1]), pk2(acc[2], acc[3]), pk2(acc[4], acc[5]), pk2(acc[6], acc[7])};
    }
}
DI void phase_final(const Params& p) {
    unsigned char* ws = launder(p.ws);
    int tid = threadIdx.x; asm volatile("" : "+v"(tid));
    const int lane = tid & 63, gw = blockIdx.x * 8 + (tid >> 6), nw = gridDim.x * 8;
    const float* ss = (const float*)(ws + OFF_SS) + (size_t)6 * NTOK * 16;
    const float* g = (const float*)(ws + OFF_FNG);
    float* out = p.out;
    const bf16_t* hb = (const bf16_t*)(ws + OFF_HB);
    f32x4 gg[4];
#pragma unroll
    for (int i = 0; i < 4; ++i) gg[i] = *(const f32x4*)(g + i * 256 + lane * 4);
    for (int row = gw; row < NTOK; row += 2 * nw) {
        const int row2 = row + nw < NTOK ? row + nw : row;
        u32x2 q[2][4]; float rs[2];
        rs[0] = row_rs(ss, row); rs[1] = row_rs(ss, row2);
#pragma unroll
        for (int i = 0; i < 4; ++i) { q[0][i] = __builtin_nontemporal_load((const u32x2*)(hb + (size_t)row * DM + i * 256 + lane * 4)); q[1][i] = __builtin_nontemporal_load((const u32x2*)(hb + (size_t)row2 * DM + i * 256 + lane * 4)); }
#pragma unroll
        for (int k = 0; k < 2; ++k)
#pragma unroll
            for (int i = 0; i < 4; ++i) {
                const f32x4 v = {__uint_as_float(q[k][i][0] << 16), __uint_as_float(q[k][i][0] & 0xffff0000u), __uint_as_float(q[k][i][1] << 16), __uint_as_float(q[k][i][1] & 0xffff0000u)};
                __builtin_nontemporal_store(v * rs[k] * gg[i], (f32x4*)(out + (size_t)(k ? row2 : row) * DM + i * 256 + lane * 4));
            }
    }
}

#define XB_TMO      128
#define XB_XCNT(j)  (256  + 64 * (j))
#define XB_XSUB(j)  (1280 + 64 * (j))
#define XB_XGEN(j)  (2304 + 64 * (j))
#define XB_TOP      3328
#define XB_TOPGEN   3392
#define XCD_BAR_WORDS 3456
#define XB_SPIN_CAP (1u << 18)
DI unsigned xb_ld(unsigned* p)              { return __hip_atomic_load(p, __ATOMIC_RELAXED, __HIP_MEMORY_SCOPE_AGENT); }
DI unsigned xb_add(unsigned* p, unsigned v) { return __hip_atomic_fetch_add(p, v, __ATOMIC_RELAXED, __HIP_MEMORY_SCOPE_AGENT); }
DI unsigned xb_xcc_id() { return (unsigned)__builtin_amdgcn_s_getreg((3 << 11) | 20) & 0xFu; }
#define XB_SPIN(cond, bar) do { unsigned _sp = 0; while (cond) { __builtin_amdgcn_s_sleep(1); \
    if ((++_sp & 255u) == 0u) { if (xb_ld(&(bar)[XB_TMO])) break; if (_sp > XB_SPIN_CAP) { atomicAdd(&(bar)[XB_TMO], 1u); break; } } } } while (0)
struct XcdBarrier { unsigned* bar; unsigned x; volatile LAS unsigned* st; };
DI XcdBarrier xcd_barrier_post(unsigned* bar, volatile LAS unsigned* st) {
    XcdBarrier b; b.bar = bar; b.x = xb_xcc_id(); b.st = st;
    if (threadIdx.x == 0) (void)xb_add(&bar[XB_XCNT(b.x)], 1u);
    return b;
}
DI void xcd_barrier_complete(unsigned* bar, unsigned x, unsigned& nloc, unsigned& nx) {
    const unsigned G = gridDim.x * gridDim.y * gridDim.z;
    unsigned sum, cnt, mine, sp = 0u;
    for (;;) {
        sum = 0u; cnt = 0u; mine = 0u;
#pragma unroll
        for (unsigned j = 0; j < 16; ++j) { const unsigned c = xb_ld(&bar[XB_XCNT(j)]); sum += c; cnt += (c > 0u) ? 1u : 0u; mine = (j == x) ? c : mine; }
        if (sum == G) break;
        __builtin_amdgcn_s_sleep(1);
        if ((++sp & 255u) == 0u) { if (xb_ld(&bar[XB_TMO])) break; if (sp > XB_SPIN_CAP) { atomicAdd(&bar[XB_TMO], 1u); break; } }
    }
    nloc = mine > 0u ? mine : 1u; nx = cnt > 0u ? cnt : 1u;
}
DI void xcd_barrier(const XcdBarrier& b) {
    asm volatile("s_waitcnt vmcnt(0)" ::: "memory");
    __syncthreads();
    if (threadIdx.x == 0) {
        unsigned* bar = b.bar;
        __builtin_amdgcn_s_waitcnt(0);
        unsigned nloc = b.st[0], nx = b.st[1];
        if (nloc == 0u) { xcd_barrier_complete(bar, b.x, nloc, nx); b.st[0] = nloc; b.st[1] = nx; }
        const unsigned old = xb_add(&bar[XB_XSUB(b.x)], 1u);
        const unsigned gen = old / nloc;
        if (old + 1u == (gen + 1u) * nloc) {
            __builtin_amdgcn_fence(__ATOMIC_RELEASE, "agent");
            asm volatile("s_waitcnt vmcnt(0)" ::: "memory");
            const unsigned og = xb_add(&bar[XB_TOP], 1u);
            const unsigned tg = og / nx;
            if (og + 1u == (tg + 1u) * nx) xb_add(&bar[XB_TOPGEN], 1u);
            else XB_SPIN(xb_ld(&bar[XB_TOPGEN]) == tg, bar);
            __builtin_amdgcn_fence(__ATOMIC_ACQUIRE, "agent");
            xb_add(&bar[XB_XGEN(b.x)], 1u);
            asm volatile("s_waitcnt vmcnt(0)" ::: "memory");
        } else {
            XB_SPIN(xb_ld(&bar[XB_XGEN(b.x)]) == gen, bar);
            __builtin_amdgcn_fence(__ATOMIC_ACQUIRE, "agent");
            asm volatile("s_waitcnt vmcnt(0)" ::: "memory");
        }
    }
    __syncthreads();
}

template <int KIND>
DI void run_phase(const Params& p, int l, int wh, unsigned char* smem) {
    LAS unsigned char* lds = (LAS unsigned char*)smem;
    unsigned char* ws = launder(p.ws);
    float* ssb = (float*)(ws + OFF_SS);
    bf16_t* HB = (bf16_t*)(ws + OFF_HB);
    if constexpr (KIND == 0) phase_prep(p, (float*)smem);
    else if constexpr (KIND == 1) {
        pg8::Gemm g{HB, (const bf16_t*)(ws + OFF_WI) + (size_t)(l * 2 + wh) * 5632 * 1024, NTOK, 5632, 1024, 1024};
        pg8::StaticOrder S; S.init(g.M, g.N, gridDim.x, blockIdx.x);
        EpiSwiglu E{ssb + (size_t)(3 * l + (wh ? 2 : 0)) * NTOK * 16, (bf16_t*)(ws + OFF_ACT)};
        pg8::gemm_phase(lds, g, S, E);
    } else if constexpr (KIND == 2) {
        pg8::Gemm g{(const bf16_t*)(ws + OFF_ACT), (const bf16_t*)(ws + OFF_WO) + (size_t)(l * 2 + wh) * 1024 * 2816, NTOK, 1024, 2816, 2816};
        EpiResid E{(l == 0 && wh == 0) ? p.in[0] : (const float*)nullptr, HB, ssb + (size_t)(3 * l + (wh ? 3 : 1)) * NTOK * 16, 0.5f};
        pg8::StaticOrder S; S.init(g.M, g.N, gridDim.x, blockIdx.x);
        pg8::gemm_phase(lds, g, S, E);
    } else if constexpr (KIND == 7) {
        pg8::Gemm g;
        if (l == 0) g = pg8::Gemm{(const bf16_t*)(ws + OFF_MIX), (const bf16_t*)(ws + OFF_EWOUT), NTOK, 1024, 1024, 1024};
        else g = pg8::Gemm{(const bf16_t*)(ws + OFF_MIX2), (const bf16_t*)(ws + OFF_OWOUT), NTOK, 1024, 512, 512};
        EpiResid E{(const float*)nullptr, HB, ssb + (size_t)(3 * l + 2) * NTOK * 16, 1.0f};
        pg8::StaticOrder S; S.init(g.M, g.N, gridDim.x, blockIdx.x);
        pg8::gemm_phase(lds, g, S, E);
    } else if constexpr (KIND == 3) {
        pg8::Gemm g{HB, (const bf16_t*)(ws + (l == 0 ? OFF_EWIN : OFF_OWIN)), NTOK, l == 0 ? 2304 : 3072, 1024, 1024};
        pg8::StaticOrder S; S.init(g.M, g.N, gridDim.x, blockIdx.x);
        EpiWin E{ssb + (size_t)(3 * l + 1) * NTOK * 16, ws, l, lds + pg8::STAGE_BYTES};
        pg8::gemm_phase(lds, g, S, E);
    } else if constexpr (KIND == 4) {
        if (blockIdx.x < 32) {
            const int kv = blockIdx.x >> 4, pm = blockIdx.x & 15;
            {
                pg8::Gemm g{(const bf16_t*)(ws + (kv ? OFF_VCIN : OFF_KCIN)), (const bf16_t*)(ws + OFF_CW1) + (size_t)kv * 256 * 2048, 4096, 256, 2048, 1024};
                pg8::OneUnit S{pm, 0};
                EpiCmp1 E{(const float*)(ws + OFF_CBIAS) + kv * 256, (bf16_t*)(ws + OFF_HID) + (size_t)kv * 4096 * 256};
                pg8::gemm_phase(lds, g, S, E);
            }
            asm volatile("s_waitcnt vmcnt(0)" ::: "memory");
            __syncthreads();
            __builtin_amdgcn_fence(__ATOMIC_ACQUIRE, "agent");
            asm volatile("s_waitcnt vmcnt(0)" ::: "memory");
            __syncthreads();
            {
                pg8::Gemm g{(const bf16_t*)(ws + OFF_HID) + (size_t)kv * 4096 * 256, (const bf16_t*)(ws + OFF_CW2) + (size_t)kv * 256 * 256, 4096, 256, 256, 256};
                pg8::OneUnit S{pm, 0};
                EpiCmp2 E{ws, kv};
                pg8::gemm_phase(lds, g, S, E);
            }
        } else {
            int tid = threadIdx.x; asm volatile("" : "+v"(tid));
            const int lane = tid & 63, wid = __builtin_amdgcn_readfirstlane(tid >> 6), r = lane & 31, h = lane >> 5;
            const int nb = gridDim.x - 32;
            int bufsel = 0; bool pre = false;
            for (int bi = blockIdx.x - 32; bi < 1024; bi += nb) item_swa(p, bi, bi + nb, wid, lane, r, h, lds, bufsel, pre);
            __syncthreads();
            prep_weights(p, (float*)smem, 0x0222u, blockIdx.x - 32, nb);
        }
    } else if constexpr (KIND == 6) {
        phase_kmean(p);
        int tid = threadIdx.x; asm volatile("" : "+v"(tid));
        const int lane = tid & 63, wid = __builtin_amdgcn_readfirstlane(tid >> 6), r = lane & 31, h = lane >> 5;
        int bufsel = 0; bool pre = false;
        for (int bi = blockIdx.x; bi < 1536; bi += gridDim.x) item_dilated(p, bi, bi + gridDim.x, wid, lane, r, h, lds, bufsel, pre);
    }
    else if constexpr (KIND == 8) phase_final(p);
    else {
        int tid = threadIdx.x; asm volatile("" : "+v"(tid));
        const int lane = tid & 63, wid = __builtin_amdgcn_readfirstlane(tid >> 6), r = lane & 31, h = lane >> 5;
        const int nb = gridDim.x;
        if constexpr (KIND == 9) {
            int bufsel = 0; bool pre = false;
            for (int bi = blockIdx.x; bi < 1024; bi += nb) item_nsa(p, bi, bi + nb, wid, lane, r, h, lds, bufsel, pre);
            __syncthreads();
            prep_weights(p, (float*)smem, 0x0CCCu, blockIdx.x, gridDim.x);
        } else {
            int bufsel = 0; bool pre = false;
            for (int bi = blockIdx.x; bi < 512; bi += nb) item_moba(p, bi, bi + nb, wid, lane, r, h, lds, bufsel, pre);
            phase_dilmerge(p);
        }
    }
}

#ifndef MULTI_LAUNCH
constexpr int N_PHASES = 20;
__global__ void __launch_bounds__(512, 2) fwd_megakernel(Params p) {
    extern __shared__ __attribute__((aligned(16))) unsigned char smem[];
    volatile LAS unsigned* xst = (volatile LAS unsigned*)((LAS unsigned char*)smem + 163840 - 64);
    if (threadIdx.x == 0) { xst[0] = 0u; xst[1] = 0u; }
    __syncthreads();
    const XcdBarrier xb = xcd_barrier_post((unsigned*)(p.ws + OFF_BAR), xst);
#define GSYNC() xcd_barrier(xb)
    if (p.coop == 2) cg::this_grid().sync();
    run_phase<0>(p, 0, 0, smem); GSYNC();
    run_phase<1>(p, 0, 0, smem); GSYNC();
    run_phase<2>(p, 0, 0, smem); GSYNC();
    run_phase<3>(p, 0, 0, smem); GSYNC();
    run_phase<4>(p, 0, 0, smem); GSYNC();
    run_phase<9>(p, 0, 0, smem); GSYNC();
    run_phase<7>(p, 0, 0, smem); GSYNC();
    run_phase<1>(p, 0, 1, smem); GSYNC();
    run_phase<2>(p, 0, 1, smem); GSYNC();
    run_phase<1>(p, 1, 0, smem); GSYNC();
    run_phase<2>(p, 1, 0, smem); GSYNC();
    run_phase<3>(p, 1, 0, smem); GSYNC();
    run_phase<6>(p, 1, 0, smem); GSYNC();
    run_phase<10>(p, 1, 0, smem); GSYNC();
    run_phase<7>(p, 1, 0, smem); GSYNC();
    run_phase<1>(p, 1, 1, smem); GSYNC();
    run_phase<2>(p, 1, 1, smem); GSYNC();
    run_phase<8>(p, 0, 0, smem);
#undef GSYNC
}

extern "C" void kernel_launch(void* const* d_in, const int* in_sizes, int n_in, void* d_out, int out_size, void* d_ws, size_t ws_size, hipStream_t stream) {
    constexpr int LDS_BYTES = 163840;
    static int grid = 0;
    if (grid == 0) {
        int dev = 0, cus = 0, per_cu = 0;
        (void)hipGetDevice(&dev);
        (void)hipDeviceGetAttribute(&cus, hipDeviceAttributeMultiprocessorCount, dev);
        (void)hipFuncSetAttribute((const void*)fwd_megakernel, hipFuncAttributeMaxDynamicSharedMemorySize, LDS_BYTES);
        (void)hipOccupancyMaxActiveBlocksPerMultiprocessor(&per_cu, (const void*)fwd_megakernel, 512, LDS_BYTES);
        (void)hipGetLastError();
        grid = (cus > 0 ? cus : 256) * 1;
        if (per_cu < 1) fprintf(stderr, "kernel_launch: occupancy query reports %d workgroups per CU\n", per_cu);
        if (ws_size < WS_END) fprintf(stderr, "kernel_launch: workspace too small: %zu < %zu\n", ws_size, (size_t)WS_END);
    }
    Params p{};
    for (int i = 0; i < 15; ++i) p.in[i] = (const float*)d_in[i];
    p.out = (float*)d_out; p.ws = (unsigned char*)d_ws;
    p.ph_lo = 0; p.ph_hi = N_PHASES; p.coop = 1; p.pad = 0;
    (void)hipMemsetAsync((unsigned char*)d_ws + OFF_BAR, 0, 16384, stream);
    void* args[] = {&p};
    hipError_t e = hipLaunchCooperativeKernel((const void*)fwd_megakernel, dim3(grid), dim3(512), args, LDS_BYTES, stream);
    if (e != hipSuccess) fprintf(stderr, "cooperative launch failed: %s (grid %d)\n", hipGetErrorString(e), grid);
}
#else
template <int KIND>
__global__ void __launch_bounds__(512, 2) k_phase(Params p, int l, int wh) {
    extern __shared__ __attribute__((aligned(16))) unsigned char smem[];
    run_phase<KIND>(p, l, wh, smem);
}
template <int KIND> static void launch_phase(const Params& p, int l, int wh, int grid, int ldsb, hipStream_t stream) {
    static bool attr = false;
    if (!attr) { (void)hipFuncSetAttribute((const void*)k_phase<KIND>, hipFuncAttributeMaxDynamicSharedMemorySize, pg8::STAGE_BYTES); attr = true; }
    hipLaunchKernelGGL(k_phase<KIND>, dim3(grid), dim3(512), ldsb, stream, p, l, wh);
}
extern "C" void kernel_launch(void* const* d_in, const int* in_sizes, int n_in, void* d_out, int out_size, void* d_ws, size_t ws_size, hipStream_t stream) {
    constexpr int LB = pg8::STAGE_BYTES;
    static int grid = 0;
    if (grid == 0) { int dev = 0, cus = 0; (void)hipGetDevice(&dev); (void)hipDeviceGetAttribute(&cus, hipDeviceAttributeMultiprocessorCount, dev); grid = cus > 0 ? cus : 256; }
    Params p{};
    for (int i = 0; i < 15; ++i) p.in[i] = (const float*)d_in[i];
    p.out = (float*)d_out; p.ws = (unsigned char*)d_ws;
    launch_phase<0>(p, 0, 0, grid, LB, stream);
    for (int l = 0; l < 2; ++l) {
        launch_phase<1>(p, l, 0, grid, LB, stream);
        launch_phase<2>(p, l, 0, grid, LB, stream);
        launch_phase<3>(p, l, 0, grid, LB, stream);
        if (l == 0) { launch_phase<4>(p, l, 0, grid, LB, stream); launch_phase<9>(p, l, 0, grid, LB, stream); }
        else { launch_phase<6>(p, l, 0, grid, LB, stream); launch_phase<10>(p, l, 0, grid, LB, stream); }
        launch_phase<7>(p, l, 0, grid, LB, stream);
        launch_phase<1>(p, l, 1, grid, LB, stream);
        launch_phase<2>(p, l, 1, grid, LB, stream);
    }
    launch_phase<8>(p, 0, 0, grid, 0, stream);
}
#endif
```

```cpp
#include <hip/hip_runtime.h>
#include <hip/hip_cooperative_groups.h>
#include <cstdio>
namespace cg = cooperative_groups;

#define LAS __attribute__((address_space(3)))
#define DI __device__ __forceinline__
typedef unsigned short bf16_t;
typedef short bf16x8 __attribute__((ext_vector_type(8)));
typedef short s16x4 __attribute__((ext_vector_type(4)));
typedef float f32x2 __attribute__((ext_vector_type(2)));
typedef float f32x4 __attribute__((ext_vector_type(4)));
typedef float f32x16 __attribute__((ext_vector_type(16)));
typedef unsigned u32x2 __attribute__((ext_vector_type(2)));
typedef unsigned u32x4 __attribute__((ext_vector_type(4)));
typedef __bf16 bf2_t __attribute__((ext_vector_type(2)));

DI unsigned pk2(float a, float b) { f32x2 v = {a, b}; bf2_t r = __builtin_convertvector(v, bf2_t); return __builtin_bit_cast(unsigned, r); }
DI float bf2f(bf16_t v) { return __uint_as_float(((unsigned)v) << 16); }
DI bf16_t f2bf(float f) { return (bf16_t)(pk2(f, 0.f) & 0xffffu); }
DI unsigned char* launder(unsigned char* p) { size_t z = 0; asm volatile("" : "+s"(z)); return p + z; }
#define MFMA32(a, b, c) __builtin_amdgcn_mfma_f32_32x32x16_bf16((a), (b), (c), 0, 0, 0)

constexpr int T = 4096, NTOK = 32768, DM = 1024, DFF = 2816;
constexpr float EPS = 1e-6f;
constexpr size_t MiB = 1048576;

constexpr size_t OFF_HB = 0;
constexpr size_t OFF_SS = OFF_HB + 64 * MiB;
constexpr size_t OFF_ROPE = OFF_SS + (size_t)7 * 32768 * 16 * 4;
constexpr size_t OFF_CBIAS = OFF_ROPE + 4096 * 32 * 8;
constexpr size_t OFF_SINK = OFF_CBIAS + 2048;
constexpr size_t OFF_FNG = OFF_CBIAS + 4096;
constexpr size_t OFF_WI = OFF_FNG + 4096;
constexpr size_t OFF_WO = OFF_WI + (size_t)4 * 5632 * 1024 * 2;
constexpr size_t OFF_EWIN = OFF_WO + (size_t)4 * 1024 * 2816 * 2;
constexpr size_t OFF_EWOUT = OFF_EWIN + (size_t)2304 * 1024 * 2;
constexpr size_t OFF_OWIN = OFF_EWOUT + (size_t)1024 * 1024 * 2;
constexpr size_t OFF_OWOUT = OFF_OWIN + (size_t)3072 * 1024 * 2;
constexpr size_t OFF_CW1 = OFF_OWOUT + (size_t)1024 * 512 * 2;
constexpr size_t OFF_CW2 = OFF_CW1 + (size_t)2 * 256 * 2048 * 2;
constexpr size_t OFF_BAR = OFF_CW2 + (size_t)2 * 256 * 256 * 2;
constexpr size_t OFF_SCR = OFF_BAR + 16384;
constexpr size_t OFF_ACT = OFF_SCR;
constexpr size_t OFF_QA = OFF_SCR;
constexpr size_t OFF_KA = OFF_QA + 32 * MiB;
constexpr size_t OFF_VTA = OFF_KA + 8 * MiB;
constexpr size_t OFF_QBG = OFF_VTA + 8 * MiB;
constexpr size_t OFF_QBR = OFF_QBG + 32 * MiB;
constexpr size_t OFF_KCIN = OFF_QBR + 32 * MiB;
constexpr size_t OFF_VCIN = OFF_KCIN + 8 * MiB;
constexpr size_t OFF_KS = OFF_VCIN + 8 * MiB + 65536;
constexpr size_t OFF_VTS = OFF_KS + 8 * MiB;
constexpr size_t OFF_KW = OFF_VTS + 8 * MiB;
constexpr size_t OFF_VTW = OFF_KW + 8 * MiB;
constexpr size_t OFF_GATE = OFF_VTW + 8 * MiB;
constexpr size_t OFF_HID = OFF_GATE + 3 * MiB;
constexpr size_t OFF_KC = OFF_HID + 4 * MiB;
constexpr size_t OFF_VTC = OFF_KC + 524288;
constexpr size_t OFF_MIX = OFF_VTC + 524288;
constexpr size_t END_EVEN = OFF_MIX + 64 * MiB;
constexpr size_t OFF_CQ = OFF_SCR;
constexpr size_t OFF_CK = OFF_CQ + 48 * MiB;
constexpr size_t OFF_VTCD = OFF_CK + 48 * MiB;
constexpr size_t OFF_DQ = OFF_VTCD + 48 * MiB;
constexpr size_t OFF_DK = OFF_DQ + 16 * MiB;
constexpr size_t OFF_VTD = OFF_DK + 16 * MiB;
constexpr size_t OFF_KMEAN = OFF_VTD + 16 * MiB;
constexpr size_t OFF_MIX2 = OFF_KMEAN + 131072;
constexpr size_t OFF_OG = OFF_MIX2 + 32 * MiB;
constexpr size_t OFF_LSEG = OFF_OG + 48 * MiB;
constexpr size_t END_ODD = OFF_LSEG + (size_t)3 * 32768 * 4 * 4;
constexpr size_t WS_END = END_EVEN > END_ODD ? END_EVEN : END_ODD;

struct Params {
    const float* in[15];
    float* out;
    unsigned char* ws;
    int ph_lo, ph_hi, coop, pad;
};

namespace pg8 {
constexpr int BM = 256, BK = 64, HALF = 128, HTB = HALF * BK * 2, STAGE_BYTES = 8 * HTB, NXCD = 8, WGM = 4;
__host__ __device__ __forceinline__ int lds_byte(int r, int c) { const int st = (r >> 4) * 2 + (c >> 5), rr = r & 15, cc = c & 31, ob = rr * 64 + cc * 2; return st * 1024 + (ob ^ (((ob >> 9) & 1) << 5)); }
__host__ __device__ __forceinline__ void stage_rc(int b, int& R, int& C) { const int st = b / 1024, sb = b % 1024, swz = sb ^ (((sb >> 9) & 1) << 5); R = (st >> 1) * 16 + swz / 64; C = (st & 1) * 32 + (swz % 64) / 2; }
struct Unit { int pm, pn; };
struct Gemm { const bf16_t* A; const bf16_t* Bt; int M, N, K, lda; };
struct StaticOrder {
    int nM, nN, nwg, G, c;
    __device__ void init(int M, int N, int G_, int c_) { nM = M / BM; nN = N / BM; nwg = nM * nN; G = G_; c = c_; }
    __device__ bool next(int i, Unit& u) const {
        const long L = (long)i * G + c; if (L >= nwg) return false;
        int wgid = (int)L; { const int q = nwg / NXCD, r = nwg % NXCD, xcd = wgid % NXCD, off = wgid / NXCD; wgid = (xcd < r ? xcd * (q + 1) : r * (q + 1) + (xcd - r) * q) + off; }
        const int nig = WGM * nN, gid = wgid / nig, fm = gid * WGM, gsz = (nM - fm) < WGM ? (nM - fm) : WGM;
        u.pm = fm + ((wgid % nig) % gsz); u.pn = (wgid % nig) / gsz; return true;
    }
};
struct OneUnit { int pm, pn; __device__ bool next(int i, Unit& u) const { if (i > 0) return false; u.pm = pm; u.pn = pn; return true; } };
template <class Epi, class Sched>
DI void gemm_phase(LAS unsigned char* lds, const Gemm g, const Sched& S, const Epi& E) {
    int tid = threadIdx.x; asm volatile("" : "+v"(tid));
    const int wid = __builtin_amdgcn_readfirstlane(tid >> 6), lane = tid & 63, wr = wid >> 2, wc = wid & 3, fr = lane & 15, fq = lane >> 4;
    const int K = g.K, nt = K / BK, lda = g.lda;
    unsigned voffA[2], voffB[2];
#pragma unroll
    for (int i = 0; i < 2; ++i) { int R, C; stage_rc(tid * 16 + i * 8192, R, C);
        voffA[i] = (unsigned)(R * lda + C) * 2u; voffB[i] = (unsigned)(R * K + C) * 2u; }
    const size_t kstep = (size_t)(BK * 2);
    const size_t hstepA = (size_t)HALF * lda * 2, hstepB = (size_t)HALF * K * 2;
    const size_t tstepA = 2 * hstepA, tstepB = 2 * hstepB;
    const unsigned ldsw = (unsigned)wid * 1024u;
    const int aoff = lds_byte(wr * 64 + fr, fq * 8), boff = lds_byte(wc * 32 + fr, fq * 8);
#define PG8_SA(b, h) (((b) * 2 + (h)) * HTB)
#define PG8_SB(b, h) ((4 + (b) * 2 + (h)) * HTB)
#define PG8_STAGE(bufoff, gbase, voff) do { _Pragma("unroll") for (int _i = 0; _i < 2; ++_i) \
        __builtin_amdgcn_global_load_lds((const unsigned*)((const char*)(gbase) + (voff)[_i]), (LAS unsigned*)(lds + (bufoff) + ldsw + _i * 8192), 16, 0, 0); } while (0)
#define PG8_LDA(dst, b, h) do { _Pragma("unroll") for (int m = 0; m < 4; ++m) _Pragma("unroll") for (int k = 0; k < 2; ++k) dst[m][k] = *(const LAS bf16x8*)(lds + PG8_SA(b, h) + aoff + m * 2048 + k * 1024); } while (0)
#define PG8_LDB(dst, b, h) do { _Pragma("unroll") for (int n = 0; n < 2; ++n) _Pragma("unroll") for (int k = 0; k < 2; ++k) dst[n][k] = *(const LAS bf16x8*)(lds + PG8_SB(b, h) + boff + n * 2048 + k * 1024); } while (0)
#define PG8_MMA(ai, bj, At, Bt) do { __builtin_amdgcn_s_setprio(1); _Pragma("unroll") for (int m = 0; m < 4; ++m) _Pragma("unroll") for (int n = 0; n < 2; ++n) _Pragma("unroll") for (int k = 0; k < 2; ++k) \
        acc[ai][bj][m][n] = __builtin_amdgcn_mfma_f32_16x16x32_bf16(Bt[n][k], At[m][k], acc[ai][bj][m][n], 0, 0, 0); __builtin_amdgcn_s_setprio(0); } while (0)
#define PG8_WAIT_V(n) asm volatile("s_waitcnt vmcnt(" #n ")" ::: "memory")
#define PG8_WAIT_L(n) asm volatile("s_waitcnt lgkmcnt(" #n ")" ::: "memory")
#define PG8_BAR __builtin_amdgcn_s_barrier()
#define PG8_SCHED __builtin_amdgcn_sched_barrier(0)
    Unit cur, nxt; int ui = 0;
    if (!S.next(0, cur)) return;
    f32x4 acc[2][2][4][2];
#pragma unroll
    for (int a = 0; a < 2; ++a)
#pragma unroll
        for (int b = 0; b < 2; ++b)
#pragma unroll
            for (int m = 0; m < 4; ++m)
#pragma unroll
                for (int n = 0; n < 2; ++n) acc[a][b][m][n] = (f32x4){0.f, 0.f, 0.f, 0.f};
    bf16x8 At[4][2], B0[2][2], B1[2][2];
    const char* cA = (const char*)g.A + (size_t)cur.pm * tstepA; const char* cB = (const char*)g.Bt + (size_t)cur.pn * tstepB;
    PG8_STAGE(PG8_SB(0, 0), cB, voffB); PG8_STAGE(PG8_SA(0, 0), cA, voffA); PG8_STAGE(PG8_SB(0, 1), cB + hstepB, voffB); PG8_STAGE(PG8_SA(0, 1), cA + hstepA, voffA);
    if (wr == 1) PG8_BAR;
    PG8_WAIT_V(4); PG8_BAR;
    PG8_STAGE(PG8_SB(1, 0), cB + kstep, voffB); PG8_STAGE(PG8_SA(1, 0), cA + kstep, voffA); PG8_STAGE(PG8_SB(1, 1), cB + hstepB + kstep, voffB);
    PG8_WAIT_V(6); PG8_BAR;
    for (;;) {
        const bool has_next = S.next(ui + 1, nxt);
        const char* nA = has_next ? (const char*)g.A + (size_t)nxt.pm * tstepA : cA; const char* nB = has_next ? (const char*)g.Bt + (size_t)nxt.pn * tstepB : cB;
        for (int t = 0; t < nt; t += 2) {
            const bool last = (t == nt - 2);
            const char* a1 = cA + (size_t)(t + 1) * kstep;
            const char* a2 = last ? nA : cA + (size_t)(t + 2) * kstep; const char* b2 = last ? nB : cB + (size_t)(t + 2) * kstep;
            const char* a3 = a2 + kstep; const char* b3 = b2 + kstep;
            PG8_LDB(B0, 0, 0); PG8_SCHED; PG8_LDA(At, 0, 0); PG8_STAGE(PG8_SA(1, 1), a1 + hstepA, voffA);
            PG8_WAIT_L(8); PG8_BAR; PG8_WAIT_L(0); PG8_MMA(0, 0, At, B0); PG8_BAR; PG8_SCHED;
            PG8_LDB(B1, 0, 1); PG8_STAGE(PG8_SB(0, 0), b2, voffB);
            PG8_BAR; PG8_WAIT_L(0); PG8_MMA(0, 1, At, B1); PG8_BAR;
            PG8_LDA(At, 0, 1); PG8_STAGE(PG8_SA(0, 0), a2, voffA);
            PG8_BAR; PG8_WAIT_L(0); PG8_MMA(1, 0, At, B0); PG8_BAR; PG8_SCHED;
            PG8_STAGE(PG8_SB(0, 1), b2 + hstepB, voffB);
            PG8_WAIT_V(6); PG8_BAR; PG8_MMA(1, 1, At, B1); PG8_BAR;
            PG8_LDB(B0, 1, 0); PG8_SCHED; PG8_LDA(At, 1, 0); PG8_STAGE(PG8_SA(0, 1), a2 + hstepA, voffA);
            PG8_WAIT_L(8); PG8_BAR; PG8_WAIT_L(0); PG8_MMA(0, 0, At, B0); PG8_BAR; PG8_SCHED;
            PG8_LDB(B1, 1, 1); PG8_STAGE(PG8_SB(1, 0), b3, voffB);
            PG8_BAR; PG8_WAIT_L(0); PG8_MMA(0, 1, At, B1); PG8_BAR;
            PG8_LDA(At, 1, 1); PG8_STAGE(PG8_SA(1, 0), a3, voffA);
            PG8_BAR; PG8_WAIT_L(0); PG8_MMA(1, 0, At, B0); PG8_BAR; PG8_SCHED;
            PG8_STAGE(PG8_SB(1, 1), b3 + hstepB, voffB);
            PG8_WAIT_V(6); PG8_BAR; PG8_MMA(1, 1, At, B1); PG8_BAR;
        }
        E(acc, cur, wr, wc, fr, fq);
        if (!has_next) break;
#pragma unroll
        for (int a = 0; a < 2; ++a)
#pragma unroll
            for (int b = 0; b < 2; ++b)
#pragma unroll
                for (int m = 0; m < 4; ++m)
#pragma unroll
                    for (int n = 0; n < 2; ++n) acc[a][b][m][n] = (f32x4){0.f, 0.f, 0.f, 0.f};
        cur = nxt; cA = nA; cB = nB; ++ui;
    }
    PG8_WAIT_V(0);
    if (wr == 0) PG8_BAR;
    PG8_BAR;
#undef PG8_SA
#undef PG8_SB
#undef PG8_STAGE
#undef PG8_LDA
#undef PG8_LDB
#undef PG8_MMA
#undef PG8_WAIT_V
#undef PG8_WAIT_L
#undef PG8_BAR
#undef PG8_SCHED
}
}
using pg8::Unit;
typedef f32x4 AccT[2][2][4][2];

DI float row_rs(const float* ss, int row) {
    const f32x4* q = (const f32x4*)(ss + (size_t)row * 16);
    const f32x4 a = q[0], b = q[1], c = q[2], d = q[3];
    const float s = ((a[0] + a[1]) + (a[2] + a[3])) + ((b[0] + b[1]) + (b[2] + b[3])) + ((c[0] + c[1]) + (c[2] + c[3])) + ((d[0] + d[1]) + (d[2] + d[3]));
    return rsqrtf(s * (1.0f / 1024.0f) + EPS);
}
struct EpiSwiglu {
    const float* ss; bf16_t* act;
    DI void operator()(const AccT& acc, const Unit& u, int wr, int wc, int fr, int fq) const {
        const int lane = fq * 16 + fr;
        float rsv[2];
#pragma unroll
        for (int ai = 0; ai < 2; ++ai) rsv[ai] = row_rs(ss, u.pm * 256 + ai * 128 + wr * 64 + lane);
#pragma unroll
        for (int ai = 0; ai < 2; ++ai)
#pragma unroll
            for (int m = 0; m < 4; ++m) {
                const int row = u.pm * 256 + ai * 128 + wr * 64 + m * 16 + fr;
                const float rs = __shfl(rsv[ai], m * 16 + fr);
                float a[8];
#pragma unroll
                for (int n = 0; n < 2; ++n)
#pragma unroll
                    for (int j = 0; j < 4; ++j) {
                        const float gt = acc[ai][0][m][n][j] * rs, up = acc[ai][1][m][n][j] * rs;
                        a[n * 4 + j] = gt * up * __builtin_amdgcn_rcpf(1.0f + __builtin_amdgcn_exp2f(gt * -1.4426950408889634f));
                    }
                u32x4 pk = {pk2(a[0], a[1]), pk2(a[2], a[3]), pk2(a[4], a[5]), pk2(a[6], a[7])};
                *(u32x4*)(act + (size_t)row * DFF + u.pn * 128 + wc * 32 + fq * 8) = pk;
            }
    }
};
struct EpiResid {
    const float* xin; bf16_t* hb; float* ssn; float scale;
    DI void operator()(const AccT& acc, const Unit& u, int wr, int wc, int fr, int fq) const {
#pragma unroll
        for (int ai = 0; ai < 2; ++ai) {
            float sq[4] = {0.f, 0.f, 0.f, 0.f};
            const int rowb = u.pm * 256 + ai * 128 + wr * 64 + fr;
#pragma unroll
            for (int bj = 0; bj < 2; ++bj) {
                const size_t ob = (size_t)rowb * DM + u.pn * 256 + bj * 128 + wc * 32 + fq * 8;
                f32x4 v0[4], v1[4];
                if (xin) {
#pragma unroll
                    for (int m = 0; m < 4; ++m) { v0[m] = __builtin_nontemporal_load((const f32x4*)(xin + ob + (size_t)m * 16 * DM)); v1[m] = __builtin_nontemporal_load((const f32x4*)(xin + ob + (size_t)m * 16 * DM + 4)); }
                } else {
                    u32x4 q[4];
#pragma unroll
                    for (int m = 0; m < 4; ++m) q[m] = *(const u32x4*)(hb + ob + (size_t)m * 16 * DM);
#pragma unroll
                    for (int m = 0; m < 4; ++m) {
                        v0[m] = (f32x4){__uint_as_float(q[m][0] << 16), __uint_as_float(q[m][0] & 0xffff0000u), __uint_as_float(q[m][1] << 16), __uint_as_float(q[m][1] & 0xffff0000u)};
                        v1[m] = (f32x4){__uint_as_float(q[m][2] << 16), __uint_as_float(q[m][2] & 0xffff0000u), __uint_as_float(q[m][3] << 16), __uint_as_float(q[m][3] & 0xffff0000u)};
                    }
                }
#pragma unroll
                for (int m = 0; m < 4; ++m) {
                    const f32x4 a0 = v0[m] + acc[ai][bj][m][0] * scale, a1 = v1[m] + acc[ai][bj][m][1] * scale;
                    *(u32x4*)(hb + ob + (size_t)m * 16 * DM) = (u32x4){pk2(a0[0], a0[1]), pk2(a0[2], a0[3]), pk2(a1[0], a1[1]), pk2(a1[2], a1[3])};
                    sq[m] += a0[0] * a0[0] + a0[1] * a0[1] + a0[2] * a0[2] + a0[3] * a0[3] + a1[0] * a1[0] + a1[1] * a1[1] + a1[2] * a1[2] + a1[3] * a1[3];
                }
            }
#pragma unroll
            for (int m = 0; m < 4; ++m) {
                float t = sq[m];
                t += __shfl_xor(t, 16);
                t += __shfl_xor(t, 32);
                if (fq == 0) ssn[(size_t)(rowb + m * 16) * 16 + u.pn * 4 + wc] = t;
            }
        }
    }
};
enum { GK_SKIP = 0, GK_PLAIN = 1, GK_ROPE = 2, GK_BOTH = 3, GK_VT = 4, GK_GATE = 5 };
struct GroupDesc { int kind; size_t off, off2; int nh, hd; };
DI GroupDesc even_desc(int G) {
    GroupDesc d; d.kind = GK_SKIP; d.off = 0; d.off2 = 0; d.nh = 2; d.hd = 0;
    if (G < 8) { d.kind = GK_ROPE; d.off = OFF_QA; d.nh = 8; d.hd = G; }
    else if (G < 10) { d.kind = GK_ROPE; d.off = OFF_KA; d.hd = G - 8; }
    else if (G < 12) { d.kind = GK_VT; d.off = OFF_VTA; d.hd = G - 10; }
    else if (G < 20) { d.kind = GK_BOTH; d.off = OFF_QBG; d.off2 = OFF_QBR; d.nh = 8; d.hd = G - 12; }
    else if (G < 22) { d.kind = GK_PLAIN; d.off = OFF_KCIN; d.hd = G - 20; }
    else if (G < 24) { d.kind = GK_PLAIN; d.off = OFF_VCIN; d.hd = G - 22; }
    else if (G < 26) { d.kind = GK_ROPE; d.off = OFF_KS; d.hd = G - 24; }
    else if (G < 28) { d.kind = GK_VT; d.off = OFF_VTS; d.hd = G - 26; }
    else if (G < 30) { d.kind = GK_ROPE; d.off = OFF_KW; d.hd = G - 28; }
    else if (G < 32) { d.kind = GK_VT; d.off = OFF_VTW; d.hd = G - 30; }
    else if (G == 32) { d.kind = GK_GATE; d.off = OFF_GATE; }
    return d;
}
DI GroupDesc odd_desc(int G) {
    GroupDesc d; d.kind = GK_SKIP; d.off = 0; d.off2 = 0; d.nh = 12; d.hd = 0;
    if (G < 12) { d.kind = GK_ROPE; d.off = OFF_CQ; d.hd = G; }
    else if (G < 24) { d.kind = GK_ROPE; d.off = OFF_CK; d.hd = G - 12; }
    else if (G < 36) { d.kind = GK_VT; d.off = OFF_VTCD; d.hd = G - 24; }
    else if (G < 40) { d.kind = GK_ROPE; d.off = OFF_DQ; d.nh = 4; d.hd = G - 36; }
    else if (G < 44) { d.kind = GK_ROPE; d.off = OFF_DK; d.nh = 4; d.hd = G - 40; }
    else { d.kind = GK_VT; d.off = OFF_VTD; d.nh = 4; d.hd = G - 44; }
    return d;
}
struct EpiWin {
    const float* ss; unsigned char* ws; int odd; LAS unsigned char* tl;
    DI void operator()(const AccT& acc, const Unit& u, int wr, int wc, int fr, int fq) const {
        const int G = u.pn * 4 + wc;
        const GroupDesc d = odd ? odd_desc(G) : even_desc(G);
        if (d.kind == GK_SKIP) return;
        const f32x4* rope = (const f32x4*)(ws + OFF_ROPE);
        const int sh = (d.kind == GK_VT && odd && d.nh == 12) ? (d.hd >= 8 ? 4 : (d.hd >= 4 ? 2 : 0)) : 0;
        if (d.kind == GK_VT && sh != 4) {
            LAS unsigned char* wl = tl + (wr * 4 + wc) * 2048;
            const int lane = fq * 16 + fr, dimr = lane >> 1, c0 = 2 * (lane & 1);
            float rsw[2];
#pragma unroll
            for (int ai = 0; ai < 2; ++ai) rsw[ai] = row_rs(ss, u.pm * 256 + ai * 128 + wr * 64 + lane);
#pragma unroll
            for (int ai = 0; ai < 2; ++ai)
#pragma unroll
                for (int mp = 0; mp < 2; ++mp) {
                    const int row0 = u.pm * 256 + ai * 128 + wr * 64 + 32 * mp;
                    const int b = row0 >> 12, t0 = row0 & 4095;
                    const float rsa = __shfl(rsw[ai], 32 * mp + fr), rsb = __shfl(rsw[ai], 32 * mp + 16 + fr);
                    bf16_t* vb = (bf16_t*)(ws + d.off) + (size_t)(b * d.nh + d.hd) * 64 * T;
#pragma unroll
                    for (int hf = 0; hf < 2; ++hf) {
#pragma unroll
                        for (int mm = 0; mm < 2; ++mm) {
                            const int tlo = 16 * mm + fr;
                            const int col = sh == 0 ? tlo : ((tlo & 3) * 8 + (tlo >> 2));
                            const float rs = mm ? rsb : rsa;
#pragma unroll
                            for (int n = 0; n < 2; ++n)
#pragma unroll
                                for (int j = 0; j < 4; ++j)
                                    *(LAS bf16_t*)(wl + ((8 * fq + 4 * n + j) * 32 + col) * 2) = f2bf(acc[ai][hf][2 * mp + mm][n][j] * rs);
                        }
#pragma unroll
                        for (int cc = 0; cc < 2; ++cc) {
                            const int c = c0 + cc;
                            const u32x4 v = *(LAS const u32x4*)(wl + (dimr * 32 + c * 8) * 2);
                            const int pos = sh == 0 ? (t0 + 8 * c) : (c * 1024 + (t0 >> 2));
                            *(u32x4*)(vb + (size_t)(32 * hf + dimr) * T + pos) = v;
                        }
                    }
                }
            return;
        }
        float rsv[2];
#pragma unroll
        for (int ai = 0; ai < 2; ++ai) rsv[ai] = row_rs(ss, u.pm * 256 + ai * 128 + wr * 64 + fq * 16 + fr);
        f32x4 csb[4], rot[4];
        const bool roped = d.kind == GK_ROPE || d.kind == GK_BOTH;
        if (roped) {
#pragma unroll
            for (int e2 = 0; e2 < 4; ++e2) rot[e2] = rope[((size_t)16 * 32 + fq * 8) / 2 + e2];
        }
#pragma unroll
        for (int ai = 0; ai < 2; ++ai) {
            if (roped) {
                const int tb0 = (u.pm * 256 + ai * 128 + wr * 64 + fr) & 4095;
#pragma unroll
                for (int e2 = 0; e2 < 4; ++e2) csb[e2] = rope[((size_t)tb0 * 32 + fq * 8) / 2 + e2];
            }
#pragma unroll
            for (int m = 0; m < 4; ++m) {
                const int row = u.pm * 256 + ai * 128 + wr * 64 + m * 16 + fr;
                const int b = row >> 12, t = row & 4095;
                const float rs = __shfl(rsv[ai], m * 16 + fr);
                float x1[8], x2[8];
#pragma unroll
                for (int n = 0; n < 2; ++n)
#pragma unroll
                    for (int j = 0; j < 4; ++j) { x1[n * 4 + j] = acc[ai][0][m][n][j] * rs; x2[n * 4 + j] = acc[ai][1][m][n][j] * rs; }
                if (d.kind == GK_GATE) {
                    if (fq < 3) {
                        float* gp = (float*)(ws + d.off) + (size_t)row * 24 + fq * 8;
                        float sg[8];
#pragma unroll
                        for (int e = 0; e < 8; ++e) sg[e] = __builtin_amdgcn_rcpf(1.0f + __builtin_amdgcn_exp2f(x1[e] * -1.4426950408889634f));
                        *(f32x4*)gp = (f32x4){sg[0], sg[1], sg[2], sg[3]};
                        *(f32x4*)(gp + 4) = (f32x4){sg[4], sg[5], sg[6], sg[7]};
                    }
                } else if (d.kind == GK_VT) {
                    const int tp = ((t & 15) << 8) + (t >> 4);
                    bf16_t* vp = (bf16_t*)(ws + d.off) + ((size_t)(b * d.nh + d.hd) * 64 + fq * 8) * T + tp;
#pragma unroll
                    for (int e = 0; e < 8; ++e) { vp[(size_t)e * T] = f2bf(x1[e]); vp[(size_t)(32 + e) * T] = f2bf(x2[e]); }
                } else {
                    const size_t ro = ((size_t)(b * d.nh + d.hd) * T + t) * 64 + fq * 8;
                    if (d.kind == GK_PLAIN || d.kind == GK_BOTH) {
                        bf16_t* dp = (bf16_t*)(ws + d.off) + ro;
                        *(u32x4*)dp = (u32x4){pk2(x1[0], x1[1]), pk2(x1[2], x1[3]), pk2(x1[4], x1[5]), pk2(x1[6], x1[7])};
                        *(u32x4*)(dp + 32) = (u32x4){pk2(x2[0], x2[1]), pk2(x2[2], x2[3]), pk2(x2[4], x2[5]), pk2(x2[6], x2[7])};
                    }
                    if (d.kind == GK_ROPE || d.kind == GK_BOTH) {
                        bf16_t* dp = (bf16_t*)(ws + (d.kind == GK_BOTH ? d.off2 : d.off)) + ro;
                        float y1[8], y2[8];
#pragma unroll
                        for (int e2 = 0; e2 < 4; ++e2) {
                            const f32x4 cs = csb[e2];
                            y1[2 * e2] = x1[2 * e2] * cs[0] - x2[2 * e2] * cs[1];       y2[2 * e2] = x2[2 * e2] * cs[0] + x1[2 * e2] * cs[1];
                            y1[2 * e2 + 1] = x1[2 * e2 + 1] * cs[2] - x2[2 * e2 + 1] * cs[3]; y2[2 * e2 + 1] = x2[2 * e2 + 1] * cs[2] + x1[2 * e2 + 1] * cs[3];
                        }
                        *(u32x4*)dp = (u32x4){pk2(y1[0], y1[1]), pk2(y1[2], y1[3]), pk2(y1[4], y1[5]), pk2(y1[6], y1[7])};
                        *(u32x4*)(dp + 32) = (u32x4){pk2(y2[0], y2[1]), pk2(y2[2], y2[3]), pk2(y2[4], y2[5]), pk2(y2[6], y2[7])};
                        if (m < 3) {
#pragma unroll
                            for (int e2 = 0; e2 < 4; ++e2) {
                                const f32x4 c = csb[e2], q = rot[e2];
                                csb[e2] = (f32x4){c[0] * q[0] - c[1] * q[1], c[1] * q[0] + c[0] * q[1], c[2] * q[2] - c[3] * q[3], c[3] * q[2] + c[2] * q[3]};
                            }
                        }
                    }
                }
            }
        }
    }
};
DI float gelu_tanh(float x) {
    const float u = 0.7978845608028654f * (x + 0.044715f * x * x * x);
    const float th = 1.0f - 2.0f / (__expf(2.0f * u) + 1.0f);
    return 0.5f * x * (1.0f + th);
}
struct EpiCmp1 {
    const float* cbias; bf16_t* hid;
    DI void operator()(const AccT& acc, const Unit& u, int wr, int wc, int fr, int fq) const {
        f32x4 cbv[2][2];
#pragma unroll
        for (int bj = 0; bj < 2; ++bj)
#pragma unroll
            for (int n = 0; n < 2; ++n) cbv[bj][n] = *(const f32x4*)(cbias + bj * 128 + wc * 32 + fq * 8 + 4 * n);
#pragma unroll
        for (int ai = 0; ai < 2; ++ai)
#pragma unroll
            for (int m = 0; m < 4; ++m) {
                const int row = u.pm * 256 + ai * 128 + wr * 64 + m * 16 + fr;
#pragma unroll
                for (int bj = 0; bj < 2; ++bj) {
                    const f32x4 v0 = acc[ai][bj][m][0] + cbv[bj][0], v1 = acc[ai][bj][m][1] + cbv[bj][1];
                    *(u32x4*)(hid + (size_t)row * 256 + bj * 128 + wc * 32 + fq * 8) =
                        (u32x4){pk2(gelu_tanh(v0[0]), gelu_tanh(v0[1])), pk2(gelu_tanh(v0[2]), gelu_tanh(v0[3])), pk2(gelu_tanh(v1[0]), gelu_tanh(v1[1])), pk2(gelu_tanh(v1[2]), gelu_tanh(v1[3]))};
                }
            }
    }
};
struct EpiCmp2 {
    unsigned char* ws; int kv;
    DI void operator()(const AccT& acc, const Unit& u, int wr, int wc, int fr, int fq) const {
        if (wc >= 2) return;
#pragma unroll
        for (int ai = 0; ai < 2; ++ai)
#pragma unroll
            for (int m = 0; m < 4; ++m) {
                const int nidx = ai * 128 + wr * 64 + m * 16 + fr;
                const float z = (nidx == 255) ? 0.f : 1.f;
#pragma unroll
                for (int n = 0; n < 2; ++n) {
                    const int col = wc * 32 + n * 16 + fq * 4;
                    const f32x4 v = acc[ai][0][m][n] * z;
                    if (kv == 0) {
                        u32x2 pk = {pk2(v[0], v[1]), pk2(v[2], v[3])};
                        *(u32x2*)((bf16_t*)(ws + OFF_KC) + ((size_t)u.pm * 256 + nidx) * 64 + col) = pk;
                    } else {
                        bf16_t* vp = (bf16_t*)(ws + OFF_VTC) + ((size_t)u.pm * 64 + col) * 256 + nidx;
#pragma unroll
                        for (int j = 0; j < 4; ++j) vp[j * 256] = f2bf(v[j]);
                    }
                }
            }
    }
};

struct AState { f32x16 o0, o1; float m, l; };
DI f32x16 zero16() { f32x16 z; for (int i = 0; i < 16; ++i) z[i] = 0.f; return z; }
DI void astate_init(AState& s) { s.o0 = zero16(); s.o1 = zero16(); s.m = -1e29f; s.l = 0.f; }
DI void load_q(bf16x8 (&qf)[4], const bf16_t* qrow, int h) {
#pragma unroll
    for (int i = 0; i < 4; ++i) qf[i] = __builtin_nontemporal_load((const bf16x8*)(qrow + 8 * h + 16 * i));
}
constexpr int LDS_KROW = 144, LDS_VROW = 528, LDS_VOFF = 256 * 144;
constexpr float LOG2E = 1.4426950408889634f, LN2 = 0.6931471805599453f;
constexpr float SCL2 = 0.125f * LOG2E;
constexpr int LDS_ABUF = 256 * 144 + 64 * 528;
DI void stage_dma(LAS unsigned char* buf, const bf16_t* Kg, const bf16_t* Vtg, int vts, int kb0, int nkeys, int wid, int lane, int kstride = 1, int koff = 0) {
    const int lrow = (lane * 57) >> 9, lpart = lane - lrow * 9;
    const int lp8 = (lpart < 8 ? lpart : 7) * 8;
    const int ninstr = (nkeys + 6) / 7;
    for (int k = wid; k < ninstr; k += 8) {
        const int row = 7 * k + lrow;
        if (lane < 63 && row < nkeys) {
            const bf16_t* src = Kg + (size_t)(koff + kstride * (kb0 + row)) * 64 + lp8;
            __builtin_amdgcn_global_load_lds((const unsigned*)src, (LAS unsigned*)(buf + k * (7 * LDS_KROW)), 16, 0, 0);
        }
    }
    for (int g0 = wid * 64; g0 < 2112; g0 += 512) {
        const int g = g0 + lane;
        const int dim = g / 33, part = g - dim * 33;
        const bf16_t* src = Vtg + (size_t)dim * vts + kb0 + (part < 32 ? part : 31) * 8;
        __builtin_amdgcn_global_load_lds((const unsigned*)src, (LAS unsigned*)(buf + LDS_VOFF + g0 * 16), 16, 0, 0);
    }
}
DI float xmax32(float x) {
    auto pr = __builtin_amdgcn_permlane32_swap(__float_as_uint(x), __float_as_uint(x), false, false);
    return fmaxf(__uint_as_float(pr[0]), __uint_as_float(pr[1]));
}
DI float xother32(float x, int h) {
    auto pr = __builtin_amdgcn_permlane32_swap(__float_as_uint(x), __float_as_uint(x), false, false);
    return __uint_as_float(h == 0 ? pr[1] : pr[0]);
}
DI int xother32i(int x, int h) {
    auto pr = __builtin_amdgcn_permlane32_swap((unsigned)x, (unsigned)x, false, false);
    return (int)(h == 0 ? pr[1] : pr[0]);
}
DI float quad_sum(float x) {
    x += __uint_as_float(__builtin_amdgcn_update_dpp(0u, __float_as_uint(x), 0xB1, 0xF, 0xF, true));
    x += __uint_as_float(__builtin_amdgcn_update_dpp(0u, __float_as_uint(x), 0x4E, 0xF, 0xF, true));
    return x;
}
DI f32x16 qk_tile_lds(const bf16x8 (&qf)[4], LAS const unsigned char* lds, int ti, int r, int h) {
    LAS const unsigned char* kp = lds + (ti * 32 + r) * LDS_KROW + h * 16;
    bf16x8 kf[4];
#pragma unroll
    for (int i = 0; i < 4; ++i) kf[i] = *(LAS const bf16x8*)(kp + 32 * i);
    f32x16 sc = zero16();
#pragma unroll
    for (int i = 0; i < 4; ++i) sc = MFMA32(kf[i], qf[i], sc);
    return sc;
}
template <bool KEYMASK, class MaskF>
DI void attn_tile(AState& st, const bf16x8 (&qf)[4], LAS const unsigned char* lds, int ti, int kb, int r, int h, bool lane_ok, const MaskF& mask) {
    LAS const unsigned char* kp = lds + (ti * 32 + r) * LDS_KROW + h * 16;
    bf16x8 kf[4];
#pragma unroll
    for (int i = 0; i < 4; ++i) kf[i] = *(LAS const bf16x8*)(kp + 32 * i);
    LAS const unsigned char* vp = lds + LDS_VOFF + r * LDS_VROW + (ti * 32 + 4 * h) * 2;
    bf16x8 vf[2][2];
#pragma unroll
    for (int g = 0; g < 2; ++g)
#pragma unroll
        for (int s = 0; s < 2; ++s) {
            const s16x4 lo = *(LAS const s16x4*)(vp + g * 32 * LDS_VROW + 32 * s);
            const s16x4 hi = *(LAS const s16x4*)(vp + g * 32 * LDS_VROW + 32 * s + 16);
            vf[g][s] = __builtin_shufflevector(lo, hi, 0, 1, 2, 3, 4, 5, 6, 7);
        }
    f32x16 sc = zero16();
#pragma unroll
    for (int i = 0; i < 4; ++i) sc = MFMA32(kf[i], qf[i], sc);
    float sv[16]; float tmax = -1e30f;
#pragma unroll
    for (int i = 0; i < 16; ++i) {
        bool ok = lane_ok;
        if (KEYMASK) { const int kpos = kb + (i & 3) + 8 * (i >> 2) + 4 * h; ok = ok && mask(kpos); }
        sv[i] = ok ? sc[i] : -1e30f;
        tmax = fmaxf(tmax, sv[i]);
    }
    tmax = xmax32(tmax);
    const float mn = fmaxf(st.m, tmax * SCL2);
    const float alpha = __builtin_amdgcn_exp2f(st.m - mn);
    float p[16]; float psum = 0.f;
#pragma unroll
    for (int i = 0; i < 16; ++i) { p[i] = __builtin_amdgcn_exp2f(__builtin_fmaf(sv[i], SCL2, -mn)); psum += p[i]; }
    const bool resc = __builtin_amdgcn_ballot_w64(mn > st.m) != 0ull;
    st.l = st.l * alpha + psum; st.m = mn;
    if (resc) { st.o0 = st.o0 * alpha; st.o1 = st.o1 * alpha; }
    const bf16x8 pf0 = __builtin_bit_cast(bf16x8, ((u32x4){pk2(p[0], p[1]), pk2(p[2], p[3]), pk2(p[4], p[5]), pk2(p[6], p[7])}));
    const bf16x8 pf1 = __builtin_bit_cast(bf16x8, ((u32x4){pk2(p[8], p[9]), pk2(p[10], p[11]), pk2(p[12], p[13]), pk2(p[14], p[15])}));
    st.o0 = MFMA32(vf[0][0], pf0, st.o0); st.o0 = MFMA32(vf[0][1], pf1, st.o0);
    st.o1 = MFMA32(vf[1][0], pf0, st.o1); st.o1 = MFMA32(vf[1][1], pf1, st.o1);
}
struct NextDesc { const bf16_t* K; const bf16_t* Vt; int vts, kb0, n, kstride, koff; bool valid; };
DI NextDesc no_next() { NextDesc d; d.K = nullptr; d.Vt = nullptr; d.vts = 0; d.kb0 = 0; d.n = 0; d.kstride = 1; d.koff = 0; d.valid = false; return d; }
DI void stage_dma_desc(LAS unsigned char* buf, const NextDesc& d, int wid, int lane) { stage_dma(buf, d.K, d.Vt, d.vts, d.kb0, d.n, wid, lane, d.kstride, d.koff); }
template <class MaskF, class WantF, class LaneF, class NeedF>
DI void attn_sweep(AState& st, const bf16x8 (&qf)[4], LAS unsigned char* lds, const bf16_t* Kg, const bf16_t* Vtg, int vts, int KB0, int KB1, int lo, int hi, int wid, int lane, int r, int h,
                   const MaskF& mask, const WantF& want, const LaneF& lanef, const NeedF& needkey, int kstride, int koff, int& bufsel, bool& pre, const NextDesc& nd) {
    if (KB0 >= KB1) return;
    if (!pre) stage_dma(lds + bufsel * LDS_ABUF, Kg, Vtg, vts, KB0, (KB1 - KB0) < 256 ? (KB1 - KB0) : 256, wid, lane, kstride, koff);
    pre = false;
#pragma unroll 1
    for (int s0 = KB0; s0 < KB1; s0 += 256, bufsel ^= 1) {
        asm volatile("s_waitcnt vmcnt(0)" ::: "memory");
        __syncthreads();
        const int nx = s0 + 256;
        if (nx < KB1) stage_dma(lds + (bufsel ^ 1) * LDS_ABUF, Kg, Vtg, vts, nx, (KB1 - nx) < 256 ? (KB1 - nx) : 256, wid, lane, kstride, koff);
        else if (nd.valid) { stage_dma_desc(lds + (bufsel ^ 1) * LDS_ABUF, nd, wid, lane); pre = true; }
        LAS const unsigned char* cur = lds + bufsel * LDS_ABUF;
        const int n = (KB1 - s0) < 256 ? (KB1 - s0) : 256, nt = n >> 5;
#pragma unroll 1
        for (int ti = 0; ti < nt; ++ti) {
            const int kb = s0 + 32 * ti;
            if (kb >= lo && kb <= hi && want(kb)) {
                if (needkey(kb)) attn_tile<true>(st, qf, cur, ti, kb, r, h, lanef(kb), mask);
                else attn_tile<false>(st, qf, cur, ti, kb, r, h, lanef(kb), mask);
            }
        }
    }
}
DI void store_o(bf16_t* dst, const f32x16& o0, const f32x16& o1, int h) {
#pragma unroll
    for (int g = 0; g < 2; ++g) {
        const f32x16& o = g ? o1 : o0;
#pragma unroll
        for (int a = 0; a < 2; ++a) {
            const unsigned ax = pk2(o[4 * a], o[4 * a + 1]), ay = pk2(o[4 * a + 2], o[4 * a + 3]);
            const unsigned bx = pk2(o[4 * a + 8], o[4 * a + 9]), by = pk2(o[4 * a + 10], o[4 * a + 11]);
            const auto rx = __builtin_amdgcn_permlane32_swap(ax, bx, false, false);
            const auto ry = __builtin_amdgcn_permlane32_swap(ay, by, false, false);
            *(u32x4*)(dst + 32 * g + 8 * (a + 2 * h)) = (u32x4){rx[0], ry[0], rx[1], ry[1]};
        }
    }
}
DI unsigned wave_or(unsigned v) {
#pragma unroll
    for (int o = 1; o < 64; o <<= 1) v |= (unsigned)__shfl_xor((int)v, o);
    return (unsigned)__builtin_amdgcn_readfirstlane((int)v);
}
struct WantAll { DI bool operator()(int) const { return true; } };
struct LaneAll { DI bool operator()(int) const { return true; } };
struct NeedAlways { DI bool operator()(int) const { return true; } };

DI NextDesc first_stage_swa(unsigned char* ws, int bi, int nitems) {
    NextDesc d = no_next();
    if (bi < nitems) {
        const int bh = bi & 63, tb = bi >> 6, T0 = tb * 256, b = bh >> 3, hk = (bh & 7) >> 2;
        d.K = (const bf16_t*)(ws + OFF_KA) + (size_t)(b * 2 + hk) * T * 64; d.Vt = (const bf16_t*)(ws + OFF_VTA) + (size_t)(b * 2 + hk) * 64 * T;
        d.vts = T; d.kb0 = T0 >= 128 ? T0 - 128 : 0; d.n = 256; d.valid = true;
    }
    return d;
}
DI void item_swa(const Params& p, int bi, int bi_next, int wid, int lane, int r, int h, LAS unsigned char* lds, int& bufsel, bool& pre) {
    asm volatile("" : "+v"(lane), "+v"(r), "+v"(h));
    unsigned char* ws = launder(p.ws);
    const int bh = bi & 63, tb = bi >> 6;
    const int T0 = tb * 256, t0 = T0 + wid * 32, b = bh >> 3, qh = bh & 7, hk = qh >> 2;
    const int tq = t0 + r;
    bf16x8 qf[4];
    load_q(qf, (const bf16_t*)(ws + OFF_QA) + ((size_t)(b * 8 + qh) * T + tq) * 64, h);
    const bf16_t* K = (const bf16_t*)(ws + OFF_KA) + (size_t)(b * 2 + hk) * T * 64;
    const bf16_t* Vt = (const bf16_t*)(ws + OFF_VTA) + (size_t)(b * 2 + hk) * 64 * T;
    AState st; astate_init(st);
    const int KB0 = T0 >= 128 ? T0 - 128 : 0;
    int lo = t0 - 127; lo = lo < 0 ? 0 : (lo & ~31);
    auto mask = [=](int kpos) { return kpos <= tq && tq - kpos <= 127; };
    auto need = [=](int kb) { return !(kb + 31 <= t0 && kb >= t0 + 31 - 127); };
    attn_sweep(st, qf, lds, K, Vt, T, KB0, T0 + 256, lo, t0, wid, lane, r, h, mask, WantAll(), LaneAll(), need, 1, 0, bufsel, pre, first_stage_swa(ws, bi_next, 1024));
    const float lt = st.l + __shfl_xor(st.l, 32);
    const float sk = ((const float*)(ws + OFF_SINK))[qh];
    const float mnat = st.m * LN2;
    const float mf = fmaxf(mnat, sk);
    const float e1 = __expf(mnat - mf);
    float den = lt * e1 + __expf(sk - mf);
    den = den > 0.f ? den : 1.f;
    const float f = e1 / den;
    store_o((bf16_t*)(ws + OFF_MIX) + (size_t)(b * T + tq) * 1024 + qh * 64, st.o0 * f, st.o1 * f, h);
}

DI void nsa_geo(int bi, int& b, int& hk, int& T0) {
    const int bh = bi & 15, tbr = bi >> 4, tk = tbr >> 4, tx = tbr & 15, tb = (tk & 1) ? (16 * tk + 15 - tx) : (16 * tk + tx);
    b = bh >> 1; hk = bh & 1; T0 = tb * 64;
}
DI NextDesc first_stage_nsa(unsigned char* ws, int bi, int nitems) {
    NextDesc d = no_next();
    if (bi < nitems) {
        int b, hk, T0; nsa_geo(bi, b, hk, T0);
        d.K = (const bf16_t*)(ws + OFF_KC) + (size_t)(b * 2 + hk) * 256 * 64; d.Vt = (const bf16_t*)(ws + OFF_VTC) + (size_t)(b * 2 + hk) * 64 * 256;
        d.vts = 256; d.kb0 = 0; d.n = ((((T0 + 63 - 31) >> 4) >> 5) + 1) * 32; d.valid = true;
    }
    return d;
}
DI void item_nsa(const Params& p, int bi, int bi_next, int wid, int lane, int r, int h, LAS unsigned char* lds, int& bufsel, bool& pre) {
    asm volatile("" : "+v"(lane), "+v"(r), "+v"(h));
    unsigned char* ws = launder(p.ws);
    int b, hk, T0; nsa_geo(bi, b, hk, T0);
    const int t0 = T0 + wid * 8;
    const int tq = t0 + (r >> 2), qh = hk * 4 + (r & 3);
    const float* gate = (const float*)(ws + OFF_GATE) + (size_t)(b * T + tq) * 24 + qh * 3;
    const float g0 = gate[0], g1 = gate[1], g2 = gate[2];
    f32x16 f0, f1;
    unsigned sel_lo = 0u, sel_hi = 0u;
    bf16x8 qf[4];
    {
        load_q(qf, (const bf16_t*)(ws + OFF_QBG) + ((size_t)(b * 8 + qh) * T + tq) * 64, h);
        const bf16_t* K = (const bf16_t*)(ws + OFF_KC) + (size_t)(b * 2 + hk) * 256 * 64;
        const bf16_t* Vt = (const bf16_t*)(ws + OFF_VTC) + (size_t)(b * 2 + hk) * 64 * 256;
        AState st; astate_init(st);
        const int nmaxb = (T0 + 63 - 31) >> 4, nmax = (t0 + 7 - 31) >> 4;
        const int KB1 = ((nmaxb >> 5) + 1) * 32;
        auto mask = [=](int n) { return 16 * n + 31 <= tq; };
        if (!pre) stage_dma(lds + bufsel * LDS_ABUF, K, Vt, 256, 0, KB1, wid, lane);
        pre = false;
        asm volatile("s_waitcnt vmcnt(0)" ::: "memory");
        __syncthreads();
        {
            NextDesc nd = no_next();
            nd.K = (const bf16_t*)(ws + OFF_KS) + (size_t)(b * 2 + hk) * T * 64; nd.Vt = (const bf16_t*)(ws + OFF_VTS) + (size_t)(b * 2 + hk) * 64 * T;
            nd.vts = T; nd.kb0 = 0; nd.n = (T0 + 64) < 256 ? (T0 + 64) : 256; nd.valid = true;
            stage_dma_desc(lds + (bufsel ^ 1) * LDS_ABUF, nd, wid, lane); pre = true;
        }
        LAS unsigned char* cbuf = lds + bufsel * LDS_ABUF;
        bufsel ^= 1;
#pragma unroll 1
        for (int ti = 0; ti < 8; ++ti) { if (32 * ti <= nmax) attn_tile<true>(st, qf, cbuf, ti, 32 * ti, r, h, true, mask); }
        const float lt = st.l + __shfl_xor(st.l, 32);
        const float inv = lt > 0.f ? 1.0f / lt : 1.0f;
        f0 = st.o0 * (inv * g0); f1 = st.o1 * (inv * g0);
        float imp[32];
        const float mfin = st.m;
        float carry = 0.f;
#pragma unroll
        for (int ti = 0; ti < 8; ++ti) {
            f32x16 sc = zero16();
            if (32 * ti <= nmax) sc = qk_tile_lds(qf, cbuf, ti, r, h);
#pragma unroll
            for (int a = 0; a < 4; ++a) {
                float pv[4];
#pragma unroll
                for (int jj = 0; jj < 4; ++jj) {
                    const int n = 32 * ti + 8 * a + 4 * h + jj;
                    pv[jj] = (32 * ti <= nmax && 16 * n + 31 <= tq) ? __builtin_amdgcn_exp2f(sc[4 * a + jj] * SCL2 - mfin) * inv : 0.f;
                }
                float mainv = pv[0] + pv[1] + pv[2] + 0.5f * pv[3];
                const float spill = 0.5f * pv[3];
                const float other = xother32(spill, h);
                mainv += (h == 1) ? other : carry;
                carry = other;
                mainv = quad_sum(mainv);
                imp[ti * 4 + a] = mainv;
            }
        }
        const int cb = tq >> 6;
        { const int f1 = cb, f2 = cb > 0 ? cb - 1 : 0;
          sel_lo |= 1u; if (f1 < 32) sel_lo |= 1u << f1; else sel_hi |= 1u << (f1 - 32); if (f2 < 32) sel_lo |= 1u << f2; else sel_hi |= 1u << (f2 - 32); }
#pragma unroll
        for (int i = 0; i < 32; ++i) {
            const int j = 8 * (i >> 2) + 2 * (i & 3) + h;
            imp[i] = (j < cb - 1 && j != 0) ? imp[i] : -1e30f;
        }
        const int nforced = cb >= 2 ? 3 : cb + 1;
        if (cb > 7) {
#pragma unroll 1
            for (int it = 0; it < 8 - nforced; ++it) {
                float bv = -3e38f; int bj = 64;
#pragma unroll
                for (int i = 0; i < 32; ++i) { if (imp[i] > bv) { bv = imp[i]; bj = 8 * (i >> 2) + 2 * (i & 3) + h; } }
                const float ov = xother32(bv, h); const int oj = xother32i(bj, h);
                if (ov > bv || (ov == bv && oj < bj)) { bv = ov; bj = oj; }
                if (bv > -5e29f) { if (bj < 32) sel_lo |= 1u << bj; else sel_hi |= 1u << (bj - 32); }
#pragma unroll
                for (int i = 0; i < 32; ++i) { if (8 * (i >> 2) + 2 * (i & 3) + h == bj) imp[i] = -3e38f; }
            }
        } else {
            sel_lo |= (2u << cb) - 1u;
        }
    }
    load_q(qf, (const bf16_t*)(ws + OFF_QBR) + ((size_t)(b * 8 + qh) * T + tq) * 64, h);
    {
        const bf16_t* K = (const bf16_t*)(ws + OFF_KS) + (size_t)(b * 2 + hk) * T * 64;
        const bf16_t* Vt = (const bf16_t*)(ws + OFF_VTS) + (size_t)(b * 2 + hk) * 64 * T;
        AState st; astate_init(st);
        const unsigned ulo = wave_or(sel_lo), uhi = wave_or(sel_hi);
        auto mask = [=](int kpos) { return kpos <= tq; };
        auto lanef = [=](int kb) { const int j = kb >> 6; return (j < 32 ? (sel_lo >> j) & 1u : (sel_hi >> (j - 32)) & 1u) != 0u; };
        auto need = [=](int kb) { return kb + 31 > t0; };
        auto want = [=](int kb) { const int j = kb >> 6; return (j < 32 ? (ulo >> j) & 1u : (uhi >> (j - 32)) & 1u) != 0u; };
        NextDesc nd = no_next();
        { const int kw0 = T0 >= 512 ? T0 - 512 : 0;
          nd.K = (const bf16_t*)(ws + OFF_KW) + (size_t)(b * 2 + hk) * T * 64; nd.Vt = (const bf16_t*)(ws + OFF_VTW) + (size_t)(b * 2 + hk) * 64 * T;
          nd.vts = T; nd.kb0 = kw0; nd.n = (T0 + 64 - kw0) < 256 ? (T0 + 64 - kw0) : 256; nd.valid = true; }
        attn_sweep(st, qf, lds, K, Vt, T, 0, T0 + 64, 0, (t0 + 7) & ~31, wid, lane, r, h, mask, want, lanef, need, 1, 0, bufsel, pre, nd);
        const float lt = st.l + __shfl_xor(st.l, 32);
        const float inv = (lt > 0.f ? 1.0f / lt : 1.0f) * g1;
        f0 = f0 + st.o0 * inv; f1 = f1 + st.o1 * inv;
    }
    {
        const bf16_t* K = (const bf16_t*)(ws + OFF_KW) + (size_t)(b * 2 + hk) * T * 64;
        const bf16_t* Vt = (const bf16_t*)(ws + OFF_VTW) + (size_t)(b * 2 + hk) * 64 * T;
        AState st; astate_init(st);
        const int KB0 = T0 >= 512 ? T0 - 512 : 0;
        int lo = t0 - 511; lo = lo < 0 ? 0 : (lo & ~31);
        auto mask = [=](int kpos) { return kpos <= tq && tq - kpos <= 511; };
        auto need = [=](int kb) { return !(kb + 31 <= t0 && kb >= t0 + 7 - 511); };
        attn_sweep(st, qf, lds, K, Vt, T, KB0, T0 + 64, lo, (t0 + 7) & ~31, wid, lane, r, h, mask, WantAll(), LaneAll(), need, 1, 0, bufsel, pre, first_stage_nsa(ws, bi_next, 1024));
        const float lt = st.l + __shfl_xor(st.l, 32);
        const float inv = (lt > 0.f ? 1.0f / lt : 1.0f) * g2;
        f0 = f0 + st.o0 * inv; f1 = f1 + st.o1 * inv;
    }
    store_o((bf16_t*)(ws + OFF_MIX) + (size_t)(b * T + tq) * 1024 + 512 + qh * 64, f0, f1, h);
}

DI void dil_geo(int bi, int& gi, int& b, int& slot, int& sh, int& rho, int& L0) {
    gi = bi >> 9; const int rem = bi & 511, bh = rem & 31, cl = rem >> 5;
    sh = gi == 0 ? 0 : (gi == 1 ? 2 : 4);
    rho = cl & ((1 << sh) - 1); L0 = (cl >> sh) * 256; b = bh >> 2; slot = bh & 3;
}
DI NextDesc first_stage_dil(unsigned char* ws, int bi, int nitems) {
    NextDesc d = no_next();
    if (bi < nitems) {
        int gi, b, slot, sh, rho, L0; dil_geo(bi, gi, b, slot, sh, rho, L0);
        const int hd = gi * 4 + slot, L = T >> sh;
        d.K = (const bf16_t*)(ws + OFF_CK) + (size_t)(b * 12 + hd) * T * 64; d.Vt = (const bf16_t*)(ws + OFF_VTCD) + (size_t)(b * 12 + hd) * 64 * T + rho * L;
        d.vts = T; d.kb0 = L0 >= 128 ? L0 - 128 : 0; d.n = 256; d.kstride = 1 << sh; d.koff = rho; d.valid = true;
    }
    return d;
}
DI void item_dilated(const Params& p, int bi, int bi_next, int wid, int lane, int r, int h, LAS unsigned char* lds, int& bufsel, bool& pre) {
    asm volatile("" : "+v"(lane), "+v"(r), "+v"(h));
    unsigned char* ws = launder(p.ws);
    int gi, b, slot, sh, rho, L0; dil_geo(bi, gi, b, slot, sh, rho, L0);
    const int rr = 1 << sh, L = T >> sh;
    const int l0 = L0 + wid * 32, hd = gi * 4 + slot;
    const int lq = l0 + r, tq = (lq << sh) + rho;
    bf16x8 qf[4];
    load_q(qf, (const bf16_t*)(ws + OFF_CQ) + ((size_t)(b * 12 + hd) * T + tq) * 64, h);
    const bf16_t* K = (const bf16_t*)(ws + OFF_CK) + (size_t)(b * 12 + hd) * T * 64;
    const bf16_t* Vt = (const bf16_t*)(ws + OFF_VTCD) + (size_t)(b * 12 + hd) * 64 * T + rho * L;
    AState st; astate_init(st);
    const int KB0 = L0 >= 128 ? L0 - 128 : 0;
    int lo = l0 - 128; lo = lo < 0 ? 0 : (lo & ~31);
    auto mask = [=](int kpos) { return kpos <= lq && lq - kpos <= 128; };
    auto need = [=](int kb) { return !(kb + 31 <= l0 && kb >= l0 + 31 - 128); };
    attn_sweep(st, qf, lds, K, Vt, T, KB0, L0 + 256, lo, l0, wid, lane, r, h, mask, WantAll(), LaneAll(), need, rr, rho, bufsel, pre, first_stage_dil(ws, bi_next, 1536));
    float lt = st.l + __shfl_xor(st.l, 32);
    lt = lt > 0.f ? lt : 1.f;
    const float inv = 1.0f / lt;
    store_o((bf16_t*)(ws + OFF_OG) + ((size_t)gi * NTOK + (size_t)b * T + tq) * 256 + slot * 64, st.o0 * inv, st.o1 * inv, h);
    if (h == 0) ((float*)(ws + OFF_LSEG))[((size_t)gi * NTOK + (size_t)b * T + tq) * 4 + slot] = st.m * LN2 + __logf(lt);
}
DI void phase_dilmerge(const Params& p) {
    unsigned char* ws = launder(p.ws);
    int tid = threadIdx.x; asm volatile("" : "+v"(tid));
    const bf16_t* og = (const bf16_t*)(ws + OFF_OG);
    const float* lse = (const float*)(ws + OFF_LSEG);
    bf16_t* mix = (bf16_t*)(ws + OFF_MIX2);
    for (int i = blockIdx.x * 512 + tid; i < NTOK * 32; i += gridDim.x * 512) {
        const int tok = i >> 5, c = i & 31, slot = c >> 3;
        const float a0 = lse[(size_t)tok * 4 + slot], a1 = lse[((size_t)NTOK + tok) * 4 + slot], a2 = lse[((size_t)2 * NTOK + tok) * 4 + slot];
        const float mx = fmaxf(a0, fmaxf(a1, a2));
        float w0 = __expf(a0 - mx), w1 = __expf(a1 - mx), w2 = __expf(a2 - mx);
        const float iw = 1.0f / (w0 + w1 + w2); w0 *= iw; w1 *= iw; w2 *= iw;
        const u32x4 x0 = __builtin_nontemporal_load((const u32x4*)(og + (size_t)tok * 256 + c * 8));
        const u32x4 x1 = __builtin_nontemporal_load((const u32x4*)(og + ((size_t)NTOK + tok) * 256 + c * 8));
        const u32x4 x2 = __builtin_nontemporal_load((const u32x4*)(og + ((size_t)2 * NTOK + tok) * 256 + c * 8));
        u32x4 o;
#pragma unroll
        for (int e = 0; e < 4; ++e) {
            const float lo = w0 * __uint_as_float(x0[e] << 16) + w1 * __uint_as_float(x1[e] << 16) + w2 * __uint_as_float(x2[e] << 16);
            const float hi = w0 * __uint_as_float(x0[e] & 0xffff0000u) + w1 * __uint_as_float(x1[e] & 0xffff0000u) + w2 * __uint_as_float(x2[e] & 0xffff0000u);
            o[e] = pk2(lo, hi);
        }
        *(u32x4*)(mix + (size_t)tok * 512 + c * 8) = o;
    }
}

DI void moba_geo(int bi, int& b, int& hd, int& cb) { const int bh = bi & 31, cbr = bi >> 5; cb = cbr < 8 ? cbr : 23 - cbr; b = bh >> 2; hd = bh & 3; }
DI NextDesc first_stage_moba(unsigned char* ws, int bi, int nitems) {
    NextDesc d = no_next();
    if (bi < nitems) {
        int b, hd, cb; moba_geo(bi, b, hd, cb);
        d.K = (const bf16_t*)(ws + OFF_DK) + (size_t)(b * 4 + hd) * T * 64; d.Vt = (const bf16_t*)(ws + OFF_VTD) + (size_t)(b * 4 + hd) * 64 * T;
        d.vts = T; d.kb0 = 0; d.n = 256; d.valid = true;
    }
    return d;
}
DI void item_moba(const Params& p, int bi, int bi_next, int wid, int lane, int r, int h, LAS unsigned char* lds, int& bufsel, bool& pre) {
    asm volatile("" : "+v"(lane), "+v"(r), "+v"(h));
    unsigned char* ws = launder(p.ws);
    int b, hd, cb; moba_geo(bi, b, hd, cb);
    const int T0 = cb * 256, t0 = T0 + wid * 32;
    const int tq = t0 + r;
    bf16x8 qf[4];
    load_q(qf, (const bf16_t*)(ws + OFF_DQ) + ((size_t)(b * 4 + hd) * T + tq) * 64, h);
    unsigned sel = 0u;
    if (cb > 0) {
        const bf16_t* kp = (const bf16_t*)(ws + OFF_KMEAN) + ((size_t)(b * 4 + hd) * 32 + r) * 64 + 8 * h;
        bf16x8 kf[4];
#pragma unroll
        for (int i = 0; i < 4; ++i) kf[i] = *(const bf16x8*)(kp + 16 * i);
        f32x16 gs = zero16();
#pragma unroll
        for (int i = 0; i < 4; ++i) gs = MFMA32(kf[i], qf[i], gs);
        float sc[8];
#pragma unroll
        for (int i = 0; i < 8; ++i) { const int n = (i & 3) + 8 * (i >> 2) + 4 * h; sc[i] = n < cb ? gs[i] : -1e30f; }
        for (int it = 0; it < 3; ++it) {
            float bv = -3e38f; int bj = 64;
#pragma unroll
            for (int i = 0; i < 8; ++i) { if (sc[i] > bv) { bv = sc[i]; bj = (i & 3) + 8 * (i >> 2) + 4 * h; } }
            const float ov = xother32(bv, h); const int oj = xother32i(bj, h);
            if (ov > bv || (ov == bv && oj < bj)) { bv = ov; bj = oj; }
            if (bv > -5e29f) sel |= 1u << bj;
#pragma unroll
            for (int i = 0; i < 8; ++i) { if ((i & 3) + 8 * (i >> 2) + 4 * h == bj) sc[i] = -3e38f; }
        }
    }
    const bf16_t* K = (const bf16_t*)(ws + OFF_DK) + (size_t)(b * 4 + hd) * T * 64;
    const bf16_t* Vt = (const bf16_t*)(ws + OFF_VTD) + (size_t)(b * 4 + hd) * 64 * T;
    AState st; astate_init(st);
    const unsigned usel = wave_or(sel);
    {
        auto mask = [=](int) { return true; };
        auto lanef = [=](int kb) { return ((sel >> (kb >> 8)) & 1u) != 0u; };
        auto want = [=](int kb) { return ((usel >> (kb >> 8)) & 1u) != 0u; };
        auto need = [=](int) { return false; };
        NextDesc nd = no_next(); nd.K = K; nd.Vt = Vt; nd.vts = T; nd.kb0 = T0; nd.n = 256; nd.valid = true;
        attn_sweep(st, qf, lds, K, Vt, T, 0, T0, 0, T0, wid, lane, r, h, mask, want, lanef, need, 1, 0, bufsel, pre, nd);
    }
    {
        auto mask = [=](int kpos) { return kpos <= tq; };
        auto need = [=](int kb) { return kb + 31 > t0; };
        attn_sweep(st, qf, lds, K, Vt, T, T0, T0 + 256, T0, t0, wid, lane, r, h, mask, WantAll(), LaneAll(), need, 1, 0, bufsel, pre, first_stage_moba(ws, bi_next, 512));
    }
    const float lt = st.l + __shfl_xor(st.l, 32);
    const float inv = lt > 0.f ? 1.0f / lt : 1.0f;
    store_o((bf16_t*)(ws + OFF_MIX2) + (size_t)(b * T + tq) * 512 + 256 + hd * 64, st.o0 * inv, st.o1 * inv, h);
}

enum { MAP_ID = 0, MAP_WI = 1, MAP_WIN = 2, MAP_PERM = 3 };
DI int map_src(int kind, int pidx, int nvalid) {
    if (kind == MAP_ID) return pidx < nvalid ? pidx : -1;
    if (kind == MAP_PERM) { const int rho = pidx & 31, n = rho >> 4, i = rho & 15; return (pidx & ~31) + 8 * (i >> 2) + 4 * n + (i & 3); }
    const int pn = pidx >> 8, q = pidx & 255, bj = q >> 7, wc = (q >> 5) & 3, n = (q >> 4) & 1, fq = (q >> 2) & 3, j = q & 3;
    if (kind == MAP_WI) return bj * DFF + 128 * pn + 32 * wc + 8 * fq + 4 * n + j;
    const int L = 256 * pn + 64 * wc + 32 * bj + 8 * fq + 4 * n + j;
    return L < nvalid ? L : -1;
}
DI void prep_tile(const float* W, int ldw, int Kdim, bf16_t* Wt, int kind, int nvalid, const float* g, int tile, float* tl) {
    const int tk = Kdim >> 7, pt = tile / tk, kt = tile - pt * tk, p0 = pt * 64, k0 = kt * 128, tid = threadIdx.x;
#pragma unroll
    for (int i = 0; i < 4; ++i) {
        const int e = tid + i * 512, kk = e >> 4, pq = (e & 15) * 4;
        const int src = map_src(kind, p0 + pq, nvalid);
        f32x4 v = {0.f, 0.f, 0.f, 0.f};
        if (src >= 0) { v = __builtin_nontemporal_load((const f32x4*)(W + (size_t)(k0 + kk) * ldw + src)); if (g) v = v * g[k0 + kk]; }
        float* d = tl + kk * 65 + pq;
        d[0] = v[0]; d[1] = v[1]; d[2] = v[2]; d[3] = v[3];
    }
    __syncthreads();
    {
        const int pp = tid >> 3, kc = (tid & 7) * 16;
        float v[16];
#pragma unroll
        for (int i = 0; i < 16; ++i) v[i] = tl[(kc + i) * 65 + pp];
        bf16_t* d = Wt + (size_t)(p0 + pp) * Kdim + k0 + kc;
        *(u32x4*)d = (u32x4){pk2(v[0], v[1]), pk2(v[2], v[3]), pk2(v[4], v[5]), pk2(v[6], v[7])};
        *(u32x4*)(d + 8) = (u32x4){pk2(v[8], v[9]), pk2(v[10], v[11]), pk2(v[12], v[13]), pk2(v[14], v[15])};
    }
    __syncthreads();
}
DI void prep_weights(const Params& p, float* tl, unsigned jobmask, int blk, int nblk);
DI void phase_prep(const Params& p, float* tl) {
    unsigned char* ws = p.ws;
    const int nblk = gridDim.x, blk = blockIdx.x, tid = threadIdx.x, lane = tid & 63, wid = tid >> 6;
    const int gw = blk * 8 + wid, nw = nblk * 8;
    {
        const float* x = p.in[0];
        bf16_t* hb = (bf16_t*)(ws + OFF_HB);
        float* ss = (float*)(ws + OFF_SS);
        for (int row = gw; row < NTOK; row += 2 * nw) {
            const int rows[2] = {row, row + nw < NTOK ? row + nw : row};
            f32x4 v[2][4];
#pragma unroll
            for (int k = 0; k < 2; ++k)
#pragma unroll
                for (int i = 0; i < 4; ++i) v[k][i] = __builtin_nontemporal_load((const f32x4*)(x + (size_t)rows[k] * DM + i * 256 + lane * 4));
#pragma unroll
            for (int k = 0; k < 2; ++k) {
                float sq = 0.f;
#pragma unroll
                for (int i = 0; i < 4; ++i) {
                    *(u32x2*)(hb + (size_t)rows[k] * DM + i * 256 + lane * 4) = (u32x2){pk2(v[k][i][0], v[k][i][1]), pk2(v[k][i][2], v[k][i][3])};
                    sq += v[k][i][0] * v[k][i][0] + v[k][i][1] * v[k][i][1] + v[k][i][2] * v[k][i][2] + v[k][i][3] * v[k][i][3];
                }
#pragma unroll
                for (int o = 1; o < 64; o <<= 1) sq += __shfl_xor(sq, o);
                if (lane < 16) ss[(size_t)rows[k] * 16 + lane] = lane == 0 ? sq : 0.f;
            }
        }
    }
    if (blk == 0) { if (tid < 8) ((float*)(ws + OFF_SINK))[tid] = p.in[8][tid]; for (int i = tid; i < 1024; i += 512) ((float*)(ws + OFF_FNG))[i] = p.in[14][i]; }
    {
        f32x2* rope = (f32x2*)(ws + OFF_ROPE);
        for (int i = blk * 512 + tid; i < T * 32; i += nblk * 512) {
            const int t = i >> 5, f = i & 31;
            const float inv = 1.0f / powf(10000.0f, (float)(2 * f) / 64.0f);
            const float ang = (float)t * inv;
            const double a = (double)ang;
            const double k = rint(a * 0.15915494309189535);
            const float rr = (float)(a - k * 6.283185307179586);
            rope[i] = (f32x2){__cosf(rr), __sinf(rr)};
        }
    }
    {
        float* cb = (float*)(ws + OFF_CBIAS);
        for (int o = gw; o < 512; o += nw) {
            const int kv = o >> 8, c = o & 255;
            const float* pe = p.in[9] + (size_t)kv * 2048;
            const float* w1 = p.in[10] + (size_t)kv * 2048 * 256;
            float s = 0.f;
            for (int i = lane; i < 2048; i += 64) s += pe[i] * w1[(size_t)i * 256 + c];
#pragma unroll
            for (int of = 1; of < 64; of <<= 1) s += __shfl_xor(s, of);
            if (lane == 0) cb[o] = s;
        }
    }
    prep_weights(p, tl, 0xF111u, blockIdx.x, gridDim.x);
}
DI void prep_weights(const Params& p, float* tl, unsigned jobmask, int blk, int nblk) {
    unsigned char* ws = launder(p.ws);
    int base = 0;
    for (int job = 0; job < 16; ++job) {
        if (!((jobmask >> job) & 1u)) continue;
        const float* W; int ldw, Kdim, P, kind, nvalid; bf16_t* Wt; const float* g = nullptr;
        if (job < 4) { const int l = job >> 1, wh = job & 1; W = p.in[4] + (size_t)job * DM * 2 * DFF; ldw = 2 * DFF; Kdim = DM; P = 2 * DFF; kind = MAP_WI; nvalid = 2 * DFF;
            Wt = (bf16_t*)(ws + OFF_WI) + (size_t)job * 5632 * 1024; g = (wh == 0 ? p.in[1] : p.in[3]) + l * DM; }
        else if (job < 8) { const int q = job - 4; W = p.in[5] + (size_t)q * DFF * DM; ldw = DM; Kdim = DFF; P = DM; kind = MAP_PERM; nvalid = DM; Wt = (bf16_t*)(ws + OFF_WO) + (size_t)q * 1024 * 2816; }
        else if (job == 8) { W = p.in[6]; ldw = 2072; Kdim = DM; P = 2304; kind = MAP_WIN; nvalid = 2072; Wt = (bf16_t*)(ws + OFF_EWIN); g = p.in[2]; }
        else if (job == 9) { W = p.in[7]; ldw = DM; Kdim = 1024; P = DM; kind = MAP_PERM; nvalid = DM; Wt = (bf16_t*)(ws + OFF_EWOUT); }
        else if (job == 10) { W = p.in[12]; ldw = 3072; Kdim = DM; P = 3072; kind = MAP_WIN; nvalid = 3072; Wt = (bf16_t*)(ws + OFF_OWIN); g = p.in[2] + DM; }
        else if (job == 11) { W = p.in[13]; ldw = DM; Kdim = 512; P = DM; kind = MAP_PERM; nvalid = DM; Wt = (bf16_t*)(ws + OFF_OWOUT); }
        else if (job < 14) { const int kv = job - 12; W = p.in[10] + (size_t)kv * 2048 * 256; ldw = 256; Kdim = 2048; P = 256; kind = MAP_PERM; nvalid = 256; Wt = (bf16_t*)(ws + OFF_CW1) + (size_t)kv * 256 * 2048; }
        else { const int kv = job - 14; W = p.in[11] + (size_t)kv * 256 * 64; ldw = 64; Kdim = 256; P = 256; kind = MAP_ID; nvalid = 64; Wt = (bf16_t*)(ws + OFF_CW2) + (size_t)kv * 256 * 256; }
        const int ntile = (P >> 6) * (Kdim >> 7);
        int first = (blk - base % nblk + nblk) % nblk;
        for (int tile = first; tile < ntile; tile += nblk) prep_tile(W, ldw, Kdim, Wt, kind, nvalid, g, tile, tl);
        base += ntile;
    }
}

DI void phase_kmean(const Params& p) {
    unsigned char* ws = launder(p.ws);
    int tid = threadIdx.x; asm volatile("" : "+v"(tid));
    const int lane = tid & 63, gw = blockIdx.x * 8 + (tid >> 6), nw = gridDim.x * 8;
    bf16_t* km = (bf16_t*)(ws + OFF_KMEAN);
    const int sub = lane >> 3, part = lane & 7;
    for (int it = gw; it < 1024; it += nw) {
        const int bh = it >> 5, n = it & 31;
        float acc[8] = {0.f, 0.f, 0.f, 0.f, 0.f, 0.f, 0.f, 0.f};
        if (n < 16) {
            const bf16_t* kp = (const bf16_t*)(ws + OFF_DK) + ((size_t)bh * T + n * 256 + sub) * 64 + part * 8;
#pragma unroll 8
            for (int i = 0; i < 32; ++i) {
                const u32x4 q = *(const u32x4*)(kp + (size_t)i * 8 * 64);
#pragma unroll
                for (int e = 0; e < 4; ++e) { acc[2 * e] += __uint_as_float(q[e] << 16); acc[2 * e + 1] += __uint_as_float(q[e] & 0xffff0000u); }
            }
#pragma unroll
            for (int e = 0; e < 8; ++e) { float t = acc[e]; t += __shfl_xor(t, 8); t += __shfl_xor(t, 16); t += __shfl_xor(t, 32); acc[e] = t * (1.0f / 256.0f); }
        }
        if (sub == 0) *(u32x4*)(km + (size_t)it * 64 + part * 8) = (u32x4){pk2(acc[0], acc[1]), pk2(acc[2], acc[3]), pk2(acc[4], acc[5]), pk2(acc[6], acc[7])};
    }
}
DI void phase_final(const Params& p) {
    unsigned char* ws = launder(p.ws);
    int tid = threadIdx.x; asm volatile("" : "+v"(tid));
    const int lane = tid & 63, gw = blockIdx.x * 8 + (tid >> 6), nw = gridDim.x * 8;
    const float* ss = (const float*)(ws + OFF_SS) + (size_t)6 * NTOK * 16;
    const float* g = (const float*)(ws + OFF_FNG);
    float* out = p.out;
    const bf16_t* hb = (const bf16_t*)(ws + OFF_HB);
    f32x4 gg[4];
#pragma unroll
    for (int i = 0; i < 4; ++i) gg[i] = *(const f32x4*)(g + i * 256 + lane * 4);
    for (int row = gw; row < NTOK; row += 2 * nw) {
        const int row2 = row + nw < NTOK ? row + nw : row;
        u32x2 q[2][4]; float rs[2];
        rs[0] = row_rs(ss, row); rs[1] = row_rs(ss, row2);
#pragma unroll
        for (int i = 0; i < 4; ++i) { q[0][i] = __builtin_nontemporal_load((const u32x2*)(hb + (size_t)row * DM + i * 256 + lane * 4)); q[1][i] = __builtin_nontemporal_load((const u32x2*)(hb + (size_t)row2 * DM + i * 256 + lane * 4)); }
#pragma unroll
        for (int k = 0; k < 2; ++k)
#pragma unroll
            for (int i = 0; i < 4; ++i) {
                const f32x4 v = {__uint_as_float(q[k][i][0] << 16), __uint_as_float(q[k][i][0] & 0xffff0000u), __uint_as_float(q[k][i][1] << 16), __uint_as_float(q[k][i][1] & 0xffff0000u)};
                __builtin_nontemporal_store(v * rs[k] * gg[i], (f32x4*)(out + (size_t)(k ? row2 : row) * DM + i * 256 + lane * 4));
            }
    }
}

#define XB_TMO      128
#define XB_XCNT(j)  (256  + 64 * (j))
#define XB_XSUB(j)  (1280 + 64 * (j))
#define XB_XGEN(j)  (2304 + 64 * (j))
#define XB_TOP      3328
#define XB_TOPGEN   3392
#define XCD_BAR_WORDS 3456
#define XB_SPIN_CAP (1u << 18)
DI unsigned xb_ld(unsigned* p)              { return __hip_atomic_load(p, __ATOMIC_RELAXED, __HIP_MEMORY_SCOPE_AGENT); }
DI unsigned xb_add(unsigned* p, unsigned v) { return __hip_atomic_fetch_add(p, v, __ATOMIC_RELAXED, __HIP_MEMORY_SCOPE_AGENT); }
DI unsigned xb_xcc_id() { return (unsigned)__builtin_amdgcn_s_getreg((3 << 11) | 20) & 0xFu; }
#define XB_SPIN(cond, bar) do { unsigned _sp = 0; while (cond) { __builtin_amdgcn_s_sleep(1); \
    if ((++_sp & 255u) == 0u) { if (xb_ld(&(bar)[XB_TMO])) break; if (_sp > XB_SPIN_CAP) { atomicAdd(&(bar)[XB_TMO], 1u); break; } } } } while (0)
struct XcdBarrier { unsigned* bar; unsigned x; volatile LAS unsigned* st; };
DI XcdBarrier xcd_barrier_post(unsigned* bar, volatile LAS unsigned* st) {
    XcdBarrier b; b.bar = bar; b.x = xb_xcc_id(); b.st = st;
    if (threadIdx.x == 0) (void)xb_add(&bar[XB_XCNT(b.x)], 1u);
    return b;
}
DI void xcd_barrier_complete(unsigned* bar, unsigned x, unsigned& nloc, unsigned& nx) {
    const unsigned G = gridDim.x * gridDim.y * gridDim.z;
    unsigned sum, cnt, mine, sp = 0u;
    for (;;) {
        sum = 0u; cnt = 0u; mine = 0u;
#pragma unroll
        for (unsigned j = 0; j < 16; ++j) { const unsigned c = xb_ld(&bar[XB_XCNT(j)]); sum += c; cnt += (c > 0u) ? 1u : 0u; mine = (j == x) ? c : mine; }
        if (sum == G) break;
        __builtin_amdgcn_s_sleep(1);
        if ((++sp & 255u) == 0u) { if (xb_ld(&bar[XB_TMO])) break; if (sp > XB_SPIN_CAP) { atomicAdd(&bar[XB_TMO], 1u); break; } }
    }
    nloc = mine > 0u ? mine : 1u; nx = cnt > 0u ? cnt : 1u;
}
DI void xcd_barrier(const XcdBarrier& b) {
    asm volatile("s_waitcnt vmcnt(0)" ::: "memory");
    __syncthreads();
    if (threadIdx.x == 0) {
        unsigned* bar = b.bar;
        __builtin_amdgcn_s_waitcnt(0);
        unsigned nloc = b.st[0], nx = b.st[1];
        if (nloc == 0u) { xcd_barrier_complete(bar, b.x, nloc, nx); b.st[0] = nloc; b.st[1] = nx; }
        const unsigned old = xb_add(&bar[XB_XSUB(b.x)], 1u);
        const unsigned gen = old / nloc;
        if (old + 1u == (gen + 1u) * nloc) {
            __builtin_amdgcn_fence(__ATOMIC_RELEASE, "agent");
            asm volatile("s_waitcnt vmcnt(0)" ::: "memory");
            const unsigned og = xb_add(&bar[XB_TOP], 1u);
            const unsigned tg = og / nx;
            if (og + 1u == (tg + 1u) * nx) xb_add(&bar[XB_TOPGEN], 1u);
            else XB_SPIN(xb_ld(&bar[XB_TOPGEN]) == tg, bar);
            __builtin_amdgcn_fence(__ATOMIC_ACQUIRE, "agent");
            xb_add(&bar[XB_XGEN(b.x)], 1u);
            asm volatile("s_waitcnt vmcnt(0)" ::: "memory");
        } else {
            XB_SPIN(xb_ld(&bar[XB_XGEN(b.x)]) == gen, bar);
            __builtin_amdgcn_fence(__ATOMIC_ACQUIRE, "agent");
            asm volatile("s_waitcnt vmcnt(0)" ::: "memory");
        }
    }
    __syncthreads();
}

template <int KIND>
DI void run_phase(const Params& p, int l, int wh, unsigned char* smem) {
    LAS unsigned char* lds = (LAS unsigned char*)smem;
    unsigned char* ws = launder(p.ws);
    float* ssb = (float*)(ws + OFF_SS);
    bf16_t* HB = (bf16_t*)(ws + OFF_HB);
    if constexpr (KIND == 0) phase_prep(p, (float*)smem);
    else if constexpr (KIND == 1) {
        pg8::Gemm g{HB, (const bf16_t*)(ws + OFF_WI) + (size_t)(l * 2 + wh) * 5632 * 1024, NTOK, 5632, 1024, 1024};
        pg8::StaticOrder S; S.init(g.M, g.N, gridDim.x, blockIdx.x);
        EpiSwiglu E{ssb + (size_t)(3 * l + (wh ? 2 : 0)) * NTOK * 16, (bf16_t*)(ws + OFF_ACT)};
        pg8::gemm_phase(lds, g, S, E);
    } else if constexpr (KIND == 2) {
        pg8::Gemm g{(const bf16_t*)(ws + OFF_ACT), (const bf16_t*)(ws + OFF_WO) + (size_t)(l * 2 + wh) * 1024 * 2816, NTOK, 1024, 2816, 2816};
        EpiResid E{(l == 0 && wh == 0) ? p.in[0] : (const float*)nullptr, HB, ssb + (size_t)(3 * l + (wh ? 3 : 1)) * NTOK * 16, 0.5f};
        pg8::StaticOrder S; S.init(g.M, g.N, gridDim.x, blockIdx.x);
        pg8::gemm_phase(lds, g, S, E);
    } else if constexpr (KIND == 7) {
        pg8::Gemm g;
        if (l == 0) g = pg8::Gemm{(const bf16_t*)(ws + OFF_MIX), (const bf16_t*)(ws + OFF_EWOUT), NTOK, 1024, 1024, 1024};
        else g = pg8::Gemm{(const bf16_t*)(ws + OFF_MIX2), (const bf16_t*)(ws + OFF_OWOUT), NTOK, 1024, 512, 512};
        EpiResid E{(const float*)nullptr, HB, ssb + (size_t)(3 * l + 2) * NTOK * 16, 1.0f};
        pg8::StaticOrder S; S.init(g.M, g.N, gridDim.x, blockIdx.x);
        pg8::gemm_phase(lds, g, S, E);
    } else if constexpr (KIND == 3) {
        pg8::Gemm g{HB, (const bf16_t*)(ws + (l == 0 ? OFF_EWIN : OFF_OWIN)), NTOK, l == 0 ? 2304 : 3072, 1024, 1024};
        pg8::StaticOrder S; S.init(g.M, g.N, gridDim.x, blockIdx.x);
        EpiWin E{ssb + (size_t)(3 * l + 1) * NTOK * 16, ws, l, lds + pg8::STAGE_BYTES};
        pg8::gemm_phase(lds, g, S, E);
    } else if constexpr (KIND == 4) {
        if (blockIdx.x < 32) {
            const int kv = blockIdx.x >> 4, pm = blockIdx.x & 15;
            {
                pg8::Gemm g{(const bf16_t*)(ws + (kv ? OFF_VCIN : OFF_KCIN)), (const bf16_t*)(ws + OFF_CW1) + (size_t)kv * 256 * 2048, 4096, 256, 2048, 1024};
                pg8::OneUnit S{pm, 0};
                EpiCmp1 E{(const float*)(ws + OFF_CBIAS) + kv * 256, (bf16_t*)(ws + OFF_HID) + (size_t)kv * 4096 * 256};
                pg8::gemm_phase(lds, g, S, E);
            }
            asm volatile("s_waitcnt vmcnt(0)" ::: "memory");
            __syncthreads();
            __builtin_amdgcn_fence(__ATOMIC_ACQUIRE, "agent");
            asm volatile("s_waitcnt vmcnt(0)" ::: "memory");
            __syncthreads();
            {
                pg8::Gemm g{(const bf16_t*)(ws + OFF_HID) + (size_t)kv * 4096 * 256, (const bf16_t*)(ws + OFF_CW2) + (size_t)kv * 256 * 256, 4096, 256, 256, 256};
                pg8::OneUnit S{pm, 0};
                EpiCmp2 E{ws, kv};
                pg8::gemm_phase(lds, g, S, E);
            }
        } else {
            int tid = threadIdx.x; asm volatile("" : "+v"(tid));
            const int lane = tid & 63, wid = __builtin_amdgcn_readfirstlane(tid >> 6), r = lane & 31, h = lane >> 5;
            const int nb = gridDim.x - 32;
            int bufsel = 0; bool pre = false;
            for (int bi = blockIdx.x - 32; bi < 1024; bi += nb) item_swa(p, bi, bi + nb, wid, lane, r, h, lds, bufsel, pre);
            __syncthreads();
            prep_weights(p, (float*)smem, 0x0222u, blockIdx.x - 32, nb);
        }
    } else if constexpr (KIND == 6) {
        phase_kmean(p);
        int tid = threadIdx.x; asm volatile("" : "+v"(tid));
        const int lane = tid & 63, wid = __builtin_amdgcn_readfirstlane(tid >> 6), r = lane & 31, h = lane >> 5;
        int bufsel = 0; bool pre = false;
        for (int bi = blockIdx.x; bi < 1536; bi += gridDim.x) item_dilated(p, bi, bi + gridDim.x, wid, lane, r, h, lds, bufsel, pre);
    }
    else if constexpr (KIND == 8) phase_final(p);
    else {
        int tid = threadIdx.x; asm volatile("" : "+v"(tid));
        const int lane = tid & 63, wid = __builtin_amdgcn_readfirstlane(tid >> 6), r = lane & 31, h = lane >> 5;
        const int nb = gridDim.x;
        if constexpr (KIND == 9) {
            int bufsel = 0; bool pre = false;
            for (int bi = blockIdx.x; bi < 1024; bi += nb) item_nsa(p, bi, bi + nb, wid, lane, r, h, lds, bufsel, pre);
            __syncthreads();
            prep_weights(p, (float*)smem, 0x0CCCu, blockIdx.x, gridDim.x);
        } else {
            int bufsel = 0; bool pre = false;
            for (int bi = blockIdx.x; bi < 512; bi += nb) item_moba(p, bi, bi + nb, wid, lane, r, h, lds, bufsel, pre);
            phase_dilmerge(p);
        }
    }
}

#ifndef MULTI_LAUNCH
constexpr int N_PHASES = 20;
__global__ void __launch_bounds__(512, 2) fwd_megakernel(Params p) {
    extern __shared__ __attribute__((aligned(16))) unsigned char smem[];
    volatile LAS unsigned* xst = (volatile LAS unsigned*)((LAS unsigned char*)smem + 163840 - 64);
    if (threadIdx.x == 0) { xst[0] = 0u; xst[1] = 0u; }
    __syncthreads();
    const XcdBarrier xb = xcd_barrier_post((unsigned*)(p.ws + OFF_BAR), xst);
#define GSYNC() xcd_barrier(xb)
    if (p.coop == 2) cg::this_grid().sync();
    run_phase<0>(p, 0, 0, smem); GSYNC();
    run_phase<1>(p, 0, 0, smem); GSYNC();
    run_phase<2>(p, 0, 0, smem); GSYNC();
    run_phase<3>(p, 0, 0, smem); GSYNC();
    run_phase<4>(p, 0, 0, smem); GSYNC();
    run_phase<9>(p, 0, 0, smem); GSYNC();
    run_phase<7>(p, 0, 0, smem); GSYNC();
    run_phase<1>(p, 0, 1, smem); GSYNC();
    run_phase<2>(p, 0, 1, smem); GSYNC();
    run_phase<1>(p, 1, 0, smem); GSYNC();
    run_phase<2>(p, 1, 0, smem); GSYNC();
    run_phase<3>(p, 1, 0, smem); GSYNC();
    run_phase<6>(p, 1, 0, smem); GSYNC();
    run_phase<10>(p, 1, 0, smem); GSYNC();
    run_phase<7>(p, 1, 0, smem); GSYNC();
    run_phase<1>(p, 1, 1, smem); GSYNC();
    run_phase<2>(p, 1, 1, smem); GSYNC();
    run_phase<8>(p, 0, 0, smem);
#undef GSYNC
}

extern "C" void kernel_launch(void* const* d_in, const int* in_sizes, int n_in, void* d_out, int out_size, void* d_ws, size_t ws_size, hipStream_t stream) {
    constexpr int LDS_BYTES = 163840;
    static int grid = 0;
    if (grid == 0) {
        int dev = 0, cus = 0, per_cu = 0;
        (void)hipGetDevice(&dev);
        (void)hipDeviceGetAttribute(&cus, hipDeviceAttributeMultiprocessorCount, dev);
        (void)hipFuncSetAttribute((const void*)fwd_megakernel, hipFuncAttributeMaxDynamicSharedMemorySize, LDS_BYTES);
        (void)hipOccupancyMaxActiveBlocksPerMultiprocessor(&per_cu, (const void*)fwd_megakernel, 512, LDS_BYTES);
        (void)hipGetLastError();
        grid = (cus > 0 ? cus : 256) * 1;
        if (per_cu < 1) fprintf(stderr, "kernel_launch: occupancy query reports %d workgroups per CU\n", per_cu);
        if (ws_size < WS_END) fprintf(stderr, "kernel_launch: workspace too small: %zu < %zu\n", ws_size, (size_t)WS_END);
    }
    Params p{};
    for (int i = 0; i < 15; ++i) p.in[i] = (const float*)d_in[i];
    p.out = (float*)d_out; p.ws = (unsigned char*)d_ws;
    p.ph_lo = 0; p.ph_hi = N_PHASES; p.coop = 1; p.pad = 0;
    (void)hipMemsetAsync((unsigned char*)d_ws + OFF_BAR, 0, 16384, stream);
    void* args[] = {&p};
    hipError_t e = hipLaunchCooperativeKernel((const void*)fwd_megakernel, dim3(grid), dim3(512), args, LDS_BYTES, stream);
    if (e != hipSuccess) fprintf(stderr, "cooperative launch failed: %s (grid %d)\n", hipGetErrorString(e), grid);
}
#else
template <int KIND>
__global__ void __launch_bounds__(512, 2) k_phase(Params p, int l, int wh) {
    extern __shared__ __attribute__((aligned(16))) unsigned char smem[];
    run_phase<KIND>(p, l, wh, smem);
}
template <int KIND> static void launch_phase(const Params& p, int l, int wh, int grid, int ldsb, hipStream_t stream) {
    static bool attr = false;
    if (!attr) { (void)hipFuncSetAttribute((const void*)k_phase<KIND>, hipFuncAttributeMaxDynamicSharedMemorySize, pg8::STAGE_BYTES); attr = true; }
    hipLaunchKernelGGL(k_phase<KIND>, dim3(grid), dim3(512), ldsb, stream, p, l, wh);
}
extern "C" void kernel_launch(void* const* d_in, const int* in_sizes, int n_in, void* d_out, int out_size, void* d_ws, size_t ws_size, hipStream_t stream) {
    constexpr int LB = pg8::STAGE_BYTES;
    static int grid = 0;
    if (grid == 0) { int dev = 0, cus = 0; (void)hipGetDevice(&dev); (void)hipDeviceGetAttribute(&cus, hipDeviceAttributeMultiprocessorCount, dev); grid = cus > 0 ? cus : 256; }
    Params p{};
    for (int i = 0; i < 15; ++i) p.in[i] = (const float*)d_in[i];
    p.out = (float*)d_out; p.ws = (unsigned char*)d_ws;
    launch_phase<0>(p, 0, 0, grid, LB, stream);
    for (int l = 0; l < 2; ++l) {
        launch_phase<1>(p, l, 0, grid, LB, stream);
        launch_phase<2>(p, l, 0, grid, LB, stream);
        launch_phase<3>(p, l, 0, grid, LB, stream);
        if (l == 0) { launch_phase<4>(p, l, 0, grid, LB, stream); launch_phase<9>(p, l, 0, grid, LB, stream); }
        else { launch_phase<6>(p, l, 0, grid, LB, stream); launch_phase<10>(p, l, 0, grid, LB, stream); }
        launch_phase<7>(p, l, 0, grid, LB, stream);
        launch_phase<1>(p, l, 1, grid, LB, stream);
        launch_phase<2>(p, l, 1, grid, LB, stream);
    }
    launch_phase<8>(p, 0, 0, grid, 0, stream);
}
#endif
```
